# Optimizing an MI355X kernel written in HIP

```python
import math
import jax, jax.numpy as jnp
from jax import lax
import numpy as np

D_MODEL = 2048
BATCH = 2
SEQ = 4096
DEPTH = 1

D_MIX = D_MODEL
MLA_HEADS = 8
MLA_NOPE_DIM = 128
MLA_ROPE_DIM = 64
MLA_V_DIM = 128
MLA_WIDTH = MLA_HEADS * MLA_V_DIM
Q_LORA_RANK = 512
KV_LORA_RANK = 256
CONV_GROUPS = 8
CONV_WIDTH = D_MIX - MLA_WIDTH
CONV_K = 3
FFN_DIM = 5632
FFN_CONV_K = 3
ROPE_THETA = 10000.0
Q_BLOCK = 128
LN_EPS = 1e-5
RMS_EPS = 1e-6
DEEPNORM_ALPHA = (2.0 * DEPTH) ** 0.25
DEEPNORM_BETA = (8.0 * DEPTH) ** -0.25
IN_PROJ_DIM = Q_LORA_RANK + KV_LORA_RANK + MLA_ROPE_DIM + 3 * CONV_WIDTH
IN_SPLITS = (Q_LORA_RANK,
             Q_LORA_RANK + KV_LORA_RANK,
             Q_LORA_RANK + KV_LORA_RANK + MLA_ROPE_DIM,
             Q_LORA_RANK + KV_LORA_RANK + MLA_ROPE_DIM + CONV_WIDTH,
             Q_LORA_RANK + KV_LORA_RANK + MLA_ROPE_DIM + 2 * CONV_WIDTH)

kernel_name = "hymba_mla_shortconv_convffn_deepnorm"


def layer_norm(x, g, b):
    x32 = x.astype(jnp.float32)
    mu = jnp.mean(x32, axis=-1, keepdims=True)
    var = jnp.mean(jnp.square(x32 - mu), axis=-1, keepdims=True)
    y = (x32 - mu) * lax.rsqrt(var + LN_EPS) * g.astype(jnp.float32) + b.astype(jnp.float32)
    return y.astype(x.dtype)


def rms_norm(x, g):
    x32 = x.astype(jnp.float32)
    y = x32 * lax.rsqrt(jnp.mean(jnp.square(x32), axis=-1, keepdims=True) + RMS_EPS)
    return (y * g.astype(jnp.float32)).astype(x.dtype)


def causal_dwconv(x, w):
    K = w.shape[0]
    S = x.shape[1]
    xp = jnp.pad(x, ((0, 0), (K - 1, 0), (0, 0)))
    y = w[K - 1] * x
    for k in range(K - 1):
        y = y + w[k] * xp[:, k:k + S]
    return y


def apply_rope(x, positions):
    D = x.shape[-1]
    inv_freq = ROPE_THETA ** (-jnp.arange(0, D, 2, dtype=jnp.float32) / D)
    ang = positions.astype(jnp.float32)[..., None] * inv_freq
    cos = jnp.cos(ang)[:, :, None, :]
    sin = jnp.sin(ang)[:, :, None, :]
    x32 = x.astype(jnp.float32)
    x1, x2 = x32[..., : D // 2], x32[..., D // 2:]
    out = jnp.concatenate([x1 * cos - x2 * sin, x1 * sin + x2 * cos], axis=-1)
    return out.astype(x.dtype)


def causal_block_attention(q, k, v):
    B, S, H, Dqk = q.shape
    Dv = v.shape[-1]
    nb = S // Q_BLOCK
    scale = Dqk ** -0.5
    qb = q.reshape(B, nb, Q_BLOCK, H, Dqk).transpose(1, 0, 2, 3, 4)
    key_pos = jnp.arange(S)

    def one_block(args):
        i, q_i = args
        s = jnp.einsum('bqhd,bkhd->bhqk', q_i, k,
                       preferred_element_type=jnp.float32) * scale
        q_pos = i * Q_BLOCK + jnp.arange(Q_BLOCK)
        mask = key_pos[None, :] <= q_pos[:, None]
        s = jnp.where(mask[None, None], s, -1e30)
        p = jax.nn.softmax(s, axis=-1)
        return jnp.einsum('bhqk,bkhd->bqhd', p.astype(v.dtype), v)

    out = lax.map(one_block, (jnp.arange(nb), qb))
    return out.transpose(1, 0, 2, 3, 4).reshape(B, S, H * Dv)


def hybrid_mixer(x, positions, w_in, q_norm_g, w_uq, kv_norm_g, w_ukv, conv_w, w_out):
    B, S, _ = x.shape
    h = jnp.einsum('bsd,de->bse', x, w_in)
    c_q, c_kv, k_r, gate_b, gate_c, x_c = jnp.split(h, IN_SPLITS, axis=-1)

    q = jnp.einsum('bsr,re->bse', rms_norm(c_q, q_norm_g), w_uq)
    q = q.reshape(B, S, MLA_HEADS, MLA_NOPE_DIM + MLA_ROPE_DIM)
    q_nope, q_rope = q[..., :MLA_NOPE_DIM], q[..., MLA_NOPE_DIM:]
    q_rope = apply_rope(q_rope, positions)
    kv = jnp.einsum('bsr,re->bse', rms_norm(c_kv, kv_norm_g), w_ukv)
    kv = kv.reshape(B, S, MLA_HEADS, MLA_NOPE_DIM + MLA_V_DIM)
    k_nope, v = kv[..., :MLA_NOPE_DIM], kv[..., MLA_NOPE_DIM:]
    k_rope = apply_rope(k_r[:, :, None, :], positions)
    q_full = jnp.concatenate([q_nope, q_rope], axis=-1)
    k_full = jnp.concatenate(
        [k_nope, jnp.broadcast_to(k_rope, (B, S, MLA_HEADS, MLA_ROPE_DIM))], axis=-1)
    attn_out = causal_block_attention(q_full, k_full, v)

    conv_out = gate_b * causal_dwconv(gate_c * x_c, conv_w)

    mixed = jnp.concatenate([attn_out, conv_out], axis=-1)
    return jnp.einsum('bse,ed->bsd', mixed, w_out)


def conv_ffn(x, w_gate_up, ffn_conv_w, w_down):
    gu = causal_dwconv(jnp.einsum('bsd,df->bsf', x, w_gate_up), ffn_conv_w)
    g, u = gu[..., :FFN_DIM], gu[..., FFN_DIM:]
    return jnp.einsum('bsf,fd->bsd', jax.nn.silu(g) * u, w_down)


def setup_inputs(seed: int = 0) -> dict:
    key = jax.random.key(seed)
    ks = jax.random.split(key, 18)
    f32 = jnp.float32

    def nrm(k, shape, scale):
        return jax.random.normal(k, shape, f32) * scale

    x = jax.random.normal(ks[0], (BATCH, SEQ, D_MODEL), f32)
    positions = jnp.broadcast_to(jnp.arange(SEQ, dtype=jnp.int32), (BATCH, SEQ))
    return {
        "x": x,
        "positions": positions,
        "w_in": nrm(ks[1], (DEPTH, D_MODEL, IN_PROJ_DIM), D_MODEL ** -0.5),
        "q_norm_g": 1.0 + nrm(ks[2], (DEPTH, Q_LORA_RANK), 0.02),
        "w_uq": nrm(ks[3], (DEPTH, Q_LORA_RANK, MLA_HEADS * (MLA_NOPE_DIM + MLA_ROPE_DIM)),
                    Q_LORA_RANK ** -0.5),
        "kv_norm_g": 1.0 + nrm(ks[4], (DEPTH, KV_LORA_RANK), 0.02),
        "w_ukv": nrm(ks[5], (DEPTH, KV_LORA_RANK, MLA_HEADS * (MLA_NOPE_DIM + MLA_V_DIM)),
                     KV_LORA_RANK ** -0.5),
        "conv_w": nrm(ks[6], (DEPTH, CONV_K, CONV_WIDTH), CONV_K ** -0.5),
        "w_out": nrm(ks[7], (DEPTH, D_MIX, D_MODEL), D_MIX ** -0.5) * DEEPNORM_BETA,
        "ln1_g": 1.0 + nrm(ks[8], (DEPTH, D_MODEL), 0.02),
        "ln1_b": nrm(ks[9], (DEPTH, D_MODEL), 0.02),
        "w_gate_up": nrm(ks[10], (DEPTH, D_MODEL, 2 * FFN_DIM), D_MODEL ** -0.5),
        "ffn_conv_w": nrm(ks[11], (DEPTH, FFN_CONV_K, 2 * FFN_DIM), FFN_CONV_K ** -0.5),
        "w_down": nrm(ks[12], (DEPTH, FFN_DIM, D_MODEL), FFN_DIM ** -0.5) * DEEPNORM_BETA,
        "ln2_g": 1.0 + nrm(ks[13], (DEPTH, D_MODEL), 0.02),
        "ln2_b": nrm(ks[14], (DEPTH, D_MODEL), 0.02),
    }


def reference(x, positions, w_in, q_norm_g, w_uq, kv_norm_g, w_ukv, conv_w, w_out,
              ln1_g, ln1_b, w_gate_up, ffn_conv_w, w_down, ln2_g, ln2_b):
    for l in range(DEPTH):
        mix = hybrid_mixer(x, positions, w_in[l], q_norm_g[l], w_uq[l], kv_norm_g[l],
                           w_ukv[l], conv_w[l], w_out[l])
        x = layer_norm(DEEPNORM_ALPHA * x + mix, ln1_g[l], ln1_b[l])
        ffn = conv_ffn(x, w_gate_up[l], ffn_conv_w[l], w_down[l])
        x = layer_norm(DEEPNORM_ALPHA * x + ffn, ln2_g[l], ln2_b[l])
    return x
```

```cpp
#include <hip/hip_runtime.h>
#include <hip/hip_cooperative_groups.h>
#include <cstdio>
#include <cstdint>
namespace cg = cooperative_groups;
namespace pg8 {
#define PG8_LAS __attribute__((address_space(3)))
typedef unsigned short bf16_t;
typedef short bf16x8 __attribute__((ext_vector_type(8)));
typedef float f32x4 __attribute__((ext_vector_type(4)));
typedef unsigned u32x4 __attribute__((ext_vector_type(4)));
constexpr int BM = 256, BK = 64, HALF = 128, HTB = HALF * BK * 2  , STAGE_BYTES = 8 * HTB, NXCD = 8, WGM = 8;

__host__ __device__ __forceinline__ int lds_byte(int r, int c) { const int st = (r >> 4) * 2 + (c >> 5), rr = r & 15, cc = c & 31, ob = rr * 64 + cc * 2; return st * 1024 + (ob ^ (((ob >> 9) & 1) << 5)); }
__host__ __device__ __forceinline__ void stage_rc(int b, int& R, int& C) { const int st = b / 1024, sb = b % 1024, swz = sb ^ (((sb >> 9) & 1) << 5); R = (st >> 1) * 16 + swz / 64; C = (st & 1) * 32 + (swz % 64) / 2; }
__host__ __device__ __forceinline__ int perm32(int rho) { const int n = rho >> 4, i = rho & 15; return 8 * (i >> 2) + 4 * n + (i & 3); }

struct Unit { int pm, pn; };
struct Gemm { const bf16_t* A; const bf16_t* Bt; int M, N, K; };

struct StaticOrder {
    int nM, nN, nwg, G, c;
    __host__ __device__ void init(int M, int N, int G_, int c_) { nM = M / BM; nN = N / BM; nwg = nM * nN; G = G_; c = c_; }
    __host__ __device__ bool next(int i, Unit& u) const {
        const long L = (long)i * G + c; if (L >= nwg) return false;
        int wgid = (int)L; { const int q = nwg / NXCD, r = nwg % NXCD, xcd = wgid % NXCD, off = wgid / NXCD; wgid = (xcd < r ? xcd * (q + 1) : r * (q + 1) + (xcd - r) * q) + off; }
        const int nig = WGM * nN, gid = wgid / nig, fm = gid * WGM, gsz = (nM - fm) < WGM ? (nM - fm) : WGM;
        u.pm = fm + ((wgid % nig) % gsz); u.pn = (wgid % nig) / gsz; return true;
    }
    __device__ __forceinline__ void a_ready(const Unit&) const {}
    __device__ __forceinline__ void done(const Unit&) const {}
};

__device__ __forceinline__ unsigned cvt_pk_bf16(float lo, float hi) { unsigned r; asm volatile("v_cvt_pk_bf16_f32 %0, %1, %2" : "=v"(r) : "v"(lo), "v"(hi)); return r; }
typedef float f32x2 __attribute__((ext_vector_type(2)));
template <class Epi, class Sched, bool ALIGN_EPI = false, bool SP2 = false>
__device__ __forceinline__ void gemm_phase(PG8_LAS unsigned char* lds, const Gemm g, const Sched& S, const Epi& E) {
    const int tid = threadIdx.x, wid = __builtin_amdgcn_readfirstlane(tid >> 6), lane = tid & 63, wr = wid >> 2, wc = wid & 3, fr = lane & 15, fq = lane >> 4;
    const int K = g.K, nt = K / BK;
    unsigned voffA[2], voffB[2];
#pragma unroll
    for (int i = 0; i < 2; ++i) { int R, C; stage_rc(tid * 16 + i * 8192, R, C); const int Rb = Epi::PERM ? ((R & ~31) + perm32(R & 31)) : R;
        voffA[i] = (unsigned)(R * K + C) * 2u; voffB[i] = (unsigned)(Rb * K + C) * 2u; }
    const size_t kstep = (size_t)(BK * 2);
    const size_t hstep = (size_t)HALF * K * 2;
    const size_t tstep = 2 * hstep;
    const unsigned ldsw = (unsigned)wid * 1024u;
    const int aoff = lds_byte(wr * 64 + fr, fq * 8), boff = lds_byte(wc * 32 + fr, fq * 8);
#define PG8_SA(b, h) (((b) * 2 + (h)) * HTB)
#define PG8_SB(b, h) ((4 + (b) * 2 + (h)) * HTB)
#define PG8_STAGE(bufoff, gbase, voff) do { _Pragma("unroll") for (int _i = 0; _i < 2; ++_i) \
        __builtin_amdgcn_global_load_lds((const unsigned*)((const char*)(gbase) + (voff)[_i]), (PG8_LAS unsigned*)(lds + (bufoff) + ldsw + _i * 8192), 16, 0, 0); } while (0)
#define PG8_LDA(dst, b, h) do { _Pragma("unroll") for (int m = 0; m < 4; ++m) _Pragma("unroll") for (int k = 0; k < 2; ++k) dst[m][k] = *(const PG8_LAS bf16x8*)(lds + PG8_SA(b, h) + aoff + m * 2048 + k * 1024); } while (0)
#define PG8_LDB(dst, b, h) do { _Pragma("unroll") for (int n = 0; n < 2; ++n) _Pragma("unroll") for (int k = 0; k < 2; ++k) dst[n][k] = *(const PG8_LAS bf16x8*)(lds + PG8_SB(b, h) + boff + n * 2048 + k * 1024); } while (0)
#define PG8_MMA(ai, bj, At, Bt) do { __builtin_amdgcn_s_setprio(1); _Pragma("unroll") for (int m = 0; m < 4; ++m) _Pragma("unroll") for (int n = 0; n < 2; ++n) _Pragma("unroll") for (int k = 0; k < 2; ++k) \
        acc[ai][bj][m][n] = __builtin_amdgcn_mfma_f32_16x16x32_bf16(Bt[n][k], At[m][k], acc[ai][bj][m][n], 0, 0, 0); __builtin_amdgcn_s_setprio(0); } while (0)
#define PG8_WAIT_V(n) asm volatile("s_waitcnt vmcnt(" #n ")" ::: "memory")
#define PG8_WAIT_L(n) asm volatile("s_waitcnt lgkmcnt(" #n ")" ::: "memory")
#define PG8_BAR __builtin_amdgcn_s_barrier()
#define PG8_SCHED __builtin_amdgcn_sched_barrier(0)
    Unit cur, nxt; int ui = 0;
    if (!S.next(0, cur)) return;
    f32x4 acc[2][2][4][2];
#pragma unroll
    for (int a = 0; a < 2; ++a)
#pragma unroll
        for (int b = 0; b < 2; ++b)
#pragma unroll
            for (int m = 0; m < 4; ++m)
#pragma unroll
                for (int n = 0; n < 2; ++n) acc[a][b][m][n] = (f32x4){0.f, 0.f, 0.f, 0.f};
    bf16x8 At[4][2], B0[2][2], B1[2][2];
    const char* cA = (const char*)g.A + (size_t)cur.pm * tstep; const char* cB = (const char*)g.Bt + (size_t)cur.pn * tstep;
    S.a_ready(cur);
    if constexpr (SP2) {
        PG8_STAGE(PG8_SB(0, 0), cB, voffB); PG8_STAGE(PG8_SB(0, 1), cB + hstep, voffB); PG8_STAGE(PG8_SA(0, 0), cA, voffA); PG8_STAGE(PG8_SA(0, 1), cA + hstep, voffA);
        if (wr == 1) PG8_BAR;
        PG8_WAIT_V(2); PG8_BAR;
        PG8_STAGE(PG8_SB(1, 0), cB + kstep, voffB); PG8_STAGE(PG8_SA(1, 0), cA + kstep, voffA); PG8_STAGE(PG8_SB(1, 1), cB + hstep + kstep, voffB);
        PG8_WAIT_V(6); PG8_BAR;
    } else {
        PG8_STAGE(PG8_SB(0, 0), cB, voffB); PG8_STAGE(PG8_SA(0, 0), cA, voffA); PG8_STAGE(PG8_SB(0, 1), cB + hstep, voffB); PG8_STAGE(PG8_SA(0, 1), cA + hstep, voffA);
        if (wr == 1) PG8_BAR;
        PG8_WAIT_V(4); PG8_BAR;
        PG8_STAGE(PG8_SB(1, 0), cB + kstep, voffB); PG8_STAGE(PG8_SA(1, 0), cA + kstep, voffA); PG8_STAGE(PG8_SB(1, 1), cB + hstep + kstep, voffB);
        PG8_WAIT_V(6); PG8_BAR;
    }
    for (;;) {
        const bool has_next = S.next(ui + 1, nxt);
        const char* nA = has_next ? (const char*)g.A + (size_t)nxt.pm * tstep : cA; const char* nB = has_next ? (const char*)g.Bt + (size_t)nxt.pn * tstep : cB;
        for (int t = 0; t < nt; t += 2) {
            const bool last = (t == nt - 2);
            const char* a1 = cA + (size_t)(t + 1) * kstep;
            const char* a2 = last ? nA : cA + (size_t)(t + 2) * kstep; const char* b2 = last ? nB : cB + (size_t)(t + 2) * kstep;
            const char* a3 = a2 + kstep; const char* b3 = b2 + kstep;
            if (last && has_next) S.a_ready(nxt);
            if constexpr (SP2) {
            PG8_LDB(B0, 0, 0); PG8_LDB(B1, 0, 1); PG8_SCHED; PG8_LDA(At, 0, 0); PG8_STAGE(PG8_SA(1, 1), a1 + hstep, voffA);
            PG8_WAIT_V(8); PG8_WAIT_L(0); PG8_BAR; PG8_MMA(0, 0, At, B0); PG8_MMA(0, 1, At, B1); PG8_BAR; PG8_SCHED;
            PG8_LDA(At, 0, 1); PG8_STAGE(PG8_SB(0, 0), b2, voffB); PG8_STAGE(PG8_SB(0, 1), b2 + hstep, voffB); PG8_STAGE(PG8_SA(0, 0), a2, voffA);
            PG8_WAIT_V(8); PG8_WAIT_L(0); PG8_BAR; PG8_MMA(1, 0, At, B0); PG8_MMA(1, 1, At, B1); PG8_BAR; PG8_SCHED;
            PG8_LDB(B0, 1, 0); PG8_LDB(B1, 1, 1); PG8_SCHED; PG8_LDA(At, 1, 0); PG8_STAGE(PG8_SA(0, 1), a2 + hstep, voffA);
            PG8_WAIT_V(8); PG8_WAIT_L(0); PG8_BAR; PG8_MMA(0, 0, At, B0); PG8_MMA(0, 1, At, B1); PG8_BAR; PG8_SCHED;
            PG8_LDA(At, 1, 1); PG8_STAGE(PG8_SB(1, 0), b3, voffB); PG8_STAGE(PG8_SB(1, 1), b3 + hstep, voffB); PG8_STAGE(PG8_SA(1, 0), a3, voffA);
            PG8_WAIT_V(8); PG8_WAIT_L(0); PG8_BAR; PG8_MMA(1, 0, At, B0); PG8_MMA(1, 1, At, B1); PG8_BAR; PG8_SCHED;
            } else {
            PG8_LDB(B0, 0, 0); PG8_SCHED; PG8_LDA(At, 0, 0); PG8_STAGE(PG8_SA(1, 1), a1 + hstep, voffA);
            PG8_WAIT_L(8); PG8_BAR; PG8_WAIT_L(0); PG8_MMA(0, 0, At, B0); PG8_BAR; PG8_SCHED;
            PG8_LDB(B1, 0, 1); PG8_STAGE(PG8_SB(0, 0), b2, voffB);
            PG8_BAR; PG8_WAIT_L(0); PG8_MMA(0, 1, At, B1); PG8_BAR;
            PG8_LDA(At, 0, 1); PG8_STAGE(PG8_SA(0, 0), a2, voffA);
            PG8_BAR; PG8_WAIT_L(0); PG8_MMA(1, 0, At, B0); PG8_BAR; PG8_SCHED;
            PG8_STAGE(PG8_SB(0, 1), b2 + hstep, voffB);
            PG8_WAIT_V(6); PG8_BAR; PG8_MMA(1, 1, At, B1); PG8_BAR;
            PG8_LDB(B0, 1, 0); PG8_SCHED; PG8_LDA(At, 1, 0); PG8_STAGE(PG8_SA(0, 1), a2 + hstep, voffA);
            PG8_WAIT_L(8); PG8_BAR; PG8_WAIT_L(0); PG8_MMA(0, 0, At, B0); PG8_BAR; PG8_SCHED;
            PG8_LDB(B1, 1, 1); PG8_STAGE(PG8_SB(1, 0), b3, voffB);
            PG8_BAR; PG8_WAIT_L(0); PG8_MMA(0, 1, At, B1); PG8_BAR;
            PG8_LDA(At, 1, 1); PG8_STAGE(PG8_SA(1, 0), a3, voffA);
            PG8_BAR; PG8_WAIT_L(0); PG8_MMA(1, 0, At, B0); PG8_BAR; PG8_SCHED;
            PG8_STAGE(PG8_SB(1, 1), b3 + hstep, voffB);
            PG8_WAIT_V(6); PG8_BAR; PG8_MMA(1, 1, At, B1); PG8_BAR;
            }
        }
        if constexpr (ALIGN_EPI) { if (wr == 0) PG8_BAR; }
        if constexpr (!Epi::AFTER_DRAIN) { E(acc, cur, wr, wc, fr, fq); S.done(cur); }
        if (!has_next) break;
#pragma unroll
        for (int a = 0; a < 2; ++a)
#pragma unroll
            for (int b = 0; b < 2; ++b)
#pragma unroll
                for (int m = 0; m < 4; ++m)
#pragma unroll
                    for (int n = 0; n < 2; ++n) acc[a][b][m][n] = (f32x4){0.f, 0.f, 0.f, 0.f};
        cur = nxt; cA = nA; cB = nB; ++ui;
        if constexpr (ALIGN_EPI) { if (wr == 1) PG8_BAR; }
    }
    PG8_WAIT_V(0);
    if constexpr (!ALIGN_EPI) { if (wr == 0) PG8_BAR; }
    PG8_BAR;
    if constexpr (Epi::AFTER_DRAIN) { E.fused(acc, cur, wr, wc, fr, fq, lds, wid, lane); S.done(cur); }
#undef PG8_SA
#undef PG8_SB
#undef PG8_STAGE
#undef PG8_LDA
#undef PG8_LDB
#undef PG8_MMA
#undef PG8_WAIT_V
#undef PG8_WAIT_L
#undef PG8_BAR
#undef PG8_SCHED
}
}
constexpr int SEQ = 4096, NBATCH = 2, M = NBATCH * SEQ, DM = 2048, NH = 8, DQK = 192, DV = 128;
constexpr int QL = 512, KVL = 256, CW = 1024, FF = 5632, NIN = 3904, NINP = 4096, NGU = 2 * FF;
constexpr float ALPHA = 1.189207115002721f;
constexpr float LN_EPS = 1e-5f, RMS_EPS = 1e-6f;

typedef unsigned short bf16;
typedef short bf16x8 __attribute__((ext_vector_type(8)));
typedef short s16x4 __attribute__((ext_vector_type(4)));
typedef float f32x4 __attribute__((ext_vector_type(4)));
typedef float f32x16 __attribute__((ext_vector_type(16)));
typedef unsigned u32x4 __attribute__((ext_vector_type(4)));
typedef unsigned u32x2 __attribute__((ext_vector_type(2)));
#define LAS __attribute__((address_space(3)))

constexpr size_t MiB = 1u << 20;
constexpr size_t WS_SSQQ = 0, WS_SSQKV = 64 * 1024;
constexpr size_t WS_CS = 1 * MiB;
constexpr size_t WS_WD = 3 * MiB, WS_WIN = 25 * MiB, WS_WUQ = 41 * MiB, WS_WUKV = 43 * MiB, WS_WOUT = 44 * MiB, WS_WGU = 52 * MiB;
constexpr size_t WS_X1B = 96 * MiB;
constexpr size_t WS_XB = 128 * MiB, WS_CQ = 160 * MiB, WS_CKV = 168 * MiB, WS_GB = 172 * MiB, WS_P = 188 * MiB;
constexpr size_t WS_Q = 204 * MiB, WS_K = 228 * MiB, WS_V = 252 * MiB, WS_MIX = 268 * MiB;
constexpr size_t WS_GU = 128 * MiB;
constexpr size_t WS_ACT = 25 * MiB;
constexpr size_t WS_PART = 304 * MiB;
constexpr size_t WS_AFLAG = 128 * 1024;
constexpr size_t WS_END = 338 * MiB;

constexpr int NWAVES = 8, NTHREADS = 512;
constexpr int LDS_BYTES = 132096;

__device__ __forceinline__ unsigned cvtpk(float lo, float hi) { unsigned r; asm volatile("v_cvt_pk_bf16_f32 %0, %1, %2" : "=v"(r) : "v"(lo), "v"(hi)); return r; }
__device__ __forceinline__ u32x4 pack8(f32x4 a, f32x4 b) { u32x4 w = {cvtpk(a[0], a[1]), cvtpk(a[2], a[3]), cvtpk(b[0], b[1]), cvtpk(b[2], b[3])}; return w; }
__device__ __forceinline__ float bf2f(unsigned short h) { return __uint_as_float(((unsigned)h) << 16); }
__device__ __forceinline__ void unpack8(u32x4 w, float* f) {
#pragma unroll
    for (int i = 0; i < 4; ++i) { f[2 * i] = __uint_as_float(w[i] << 16); f[2 * i + 1] = __uint_as_float(w[i] & 0xffff0000u); }
}

struct Epi {
    static constexpr bool PERM = true, AFTER_DRAIN = false;
    int mode;
    bf16 *CQ, *CKV, *GB, *P, *Q, *K, *V, *GU;
    float *ssq_q, *ssq_kv; const float* cs; const float* x; float* out;
    __device__ __forceinline__ void operator()(const f32x4 (&acc)[2][2][4][2], const pg8::Unit& u, int wr, int wc, int fr, int fq) const {
        const int pn = u.pn, cb = wc * 32 + 8 * fq;
        const int rbase = u.pm * 256 + wr * 64 + fr;
        if (mode == 1) {
            if (pn < 3) {
#pragma unroll
                for (int ai = 0; ai < 2; ++ai)
#pragma unroll
                    for (int m = 0; m < 4; ++m) {
                        const int row = rbase + ai * 128 + m * 16;
                        bf16* dst = (pn < 2) ? (CQ + (size_t)row * QL + pn * 256) : (CKV + (size_t)row * KVL);
                        float ss = 0.f;
#pragma unroll
                        for (int bj = 0; bj < 2; ++bj) { const f32x4 v0 = acc[ai][bj][m][0], v1 = acc[ai][bj][m][1];
                            ss += (v0[0] * v0[0] + v0[1] * v0[1]) + (v0[2] * v0[2] + v0[3] * v0[3]) + (v1[0] * v1[0] + v1[1] * v1[1]) + (v1[2] * v1[2] + v1[3] * v1[3]);
                            *(u32x4*)(dst + bj * 128 + cb) = pack8(v0, v1); }
                        ss += __shfl_xor(ss, 16); ss += __shfl_xor(ss, 32);
                        if (fq == 0) atomicAdd(((pn < 2) ? ssq_q : ssq_kv) + row, ss);
                    }
            } else if (pn == 3) {
                if (wc == 0) {
#pragma unroll
                    for (int ai = 0; ai < 2; ++ai)
#pragma unroll
                        for (int m = 0; m < 4; ++m) {
                            const int row = rbase + ai * 128 + m * 16;
                            const float* c = cs + (size_t)row * 64 + 8 * fq;
                            const f32x4 c0 = *(const f32x4*)c, c1 = *(const f32x4*)(c + 4), s0 = *(const f32x4*)(c + 32), s1 = *(const f32x4*)(c + 36);
                            const f32x4 a0 = acc[ai][0][m][0], a1 = acc[ai][0][m][1], b0 = acc[ai][1][m][0], b1 = acc[ai][1][m][1];
                            const u32x4 o1 = pack8(a0 * c0 - b0 * s0, a1 * c1 - b1 * s1), o2 = pack8(a0 * s0 + b0 * c0, a1 * s1 + b1 * c1);
                            const int b = row >> 12, s_ = row & 4095;
#pragma unroll
                            for (int h = 0; h < NH; ++h) { bf16* kp = K + ((size_t)(b * NH + h) * SEQ + s_) * DQK + 128 + 8 * fq;
                                *(u32x4*)kp = o1; *(u32x4*)(kp + 32) = o2; }
                        }
                }
            } else if (pn < 8) {
#pragma unroll
                for (int ai = 0; ai < 2; ++ai)
#pragma unroll
                    for (int m = 0; m < 4; ++m) { const int row = rbase + ai * 128 + m * 16;
#pragma unroll
                        for (int bj = 0; bj < 2; ++bj) *(u32x4*)(GB + (size_t)row * CW + (pn - 4) * 256 + bj * 128 + cb) = pack8(acc[ai][bj][m][0], acc[ai][bj][m][1]); }
            } else {
#pragma unroll
                for (int ai = 0; ai < 2; ++ai)
#pragma unroll
                    for (int m = 0; m < 4; ++m) { const int row = rbase + ai * 128 + m * 16;
                        *(u32x4*)(P + (size_t)row * CW + (pn - 8) * 128 + cb) = pack8(acc[ai][0][m][0] * acc[ai][1][m][0], acc[ai][0][m][1] * acc[ai][1][m][1]); }
            }
        } else if (mode == 2) {
#pragma unroll
            for (int ai = 0; ai < 2; ++ai)
#pragma unroll
                for (int m = 0; m < 4; ++m) {
                    const int row = rbase + ai * 128 + m * 16; const int b = row >> 12, s_ = row & 4095;
                    const float rs = 1.0f / sqrtf(ssq_q[row] * (1.0f / QL) + RMS_EPS);
                    if (pn < 4) {
#pragma unroll
                        for (int bj = 0; bj < 2; ++bj) { const int head = 2 * pn + bj;
                            *(u32x4*)(Q + ((size_t)(b * NH + head) * SEQ + s_) * DQK + cb) = pack8(acc[ai][bj][m][0] * rs, acc[ai][bj][m][1] * rs); }
                    } else {
                        const int head = (pn - 4) * 4 + wc;
                        const float* c = cs + (size_t)row * 64 + 8 * fq;
                        const f32x4 c0 = *(const f32x4*)c, c1 = *(const f32x4*)(c + 4), s0 = *(const f32x4*)(c + 32), s1 = *(const f32x4*)(c + 36);
                        const f32x4 a0 = acc[ai][0][m][0] * rs, a1 = acc[ai][0][m][1] * rs, b0 = acc[ai][1][m][0] * rs, b1 = acc[ai][1][m][1] * rs;
                        bf16* qp = Q + ((size_t)(b * NH + head) * SEQ + s_) * DQK + 128 + 8 * fq;
                        *(u32x4*)qp = pack8(a0 * c0 - b0 * s0, a1 * c1 - b1 * s1); *(u32x4*)(qp + 32) = pack8(a0 * s0 + b0 * c0, a1 * s1 + b1 * c1);
                    }
                }
        } else if (mode == 3) {
#pragma unroll
            for (int ai = 0; ai < 2; ++ai)
#pragma unroll
                for (int m = 0; m < 4; ++m) {
                    const int row = rbase + ai * 128 + m * 16; const int b = row >> 12, s_ = row & 4095;
                    const float rs = 1.0f / sqrtf(ssq_kv[row] * (1.0f / KVL) + RMS_EPS);
                    const size_t tok = (size_t)(b * NH + pn) * SEQ + s_;
                    *(u32x4*)(K + tok * DQK + cb) = pack8(acc[ai][0][m][0] * rs, acc[ai][0][m][1] * rs);
                    *(u32x4*)(V + tok * DV + cb) = pack8(acc[ai][1][m][0] * rs, acc[ai][1][m][1] * rs);
                }
        } else if (mode == 4) {
#pragma unroll
            for (int ai = 0; ai < 2; ++ai)
#pragma unroll
                for (int m = 0; m < 4; ++m) { const int row = rbase + ai * 128 + m * 16;
#pragma unroll
                    for (int bj = 0; bj < 2; ++bj) { const size_t idx = (size_t)row * DM + pn * 256 + bj * 128 + cb;
                        const f32x4 x0 = *(const f32x4*)(x + idx), x1 = *(const f32x4*)(x + idx + 4);
                        *(f32x4*)(out + idx) = x0 * ALPHA + acc[ai][bj][m][0]; *(f32x4*)(out + idx + 4) = x1 * ALPHA + acc[ai][bj][m][1]; } }
        } else if (mode == 5) {
#pragma unroll
            for (int ai = 0; ai < 2; ++ai)
#pragma unroll
                for (int m = 0; m < 4; ++m) { const int row = rbase + ai * 128 + m * 16;
#pragma unroll
                    for (int bj = 0; bj < 2; ++bj) *(u32x4*)(GU + (size_t)row * NGU + pn * 256 + bj * 128 + cb) = pack8(acc[ai][bj][m][0], acc[ai][bj][m][1]); }
        } else {
#pragma unroll
            for (int ai = 0; ai < 2; ++ai)
#pragma unroll
                for (int m = 0; m < 4; ++m) { const int row = rbase + ai * 128 + m * 16;
#pragma unroll
                    for (int bj = 0; bj < 2; ++bj) { const size_t idx = (size_t)row * DM + pn * 256 + bj * 128 + cb;
                        const f32x4 x0 = *(const f32x4*)(out + idx), x1 = *(const f32x4*)(out + idx + 4);
                        *(f32x4*)(out + idx) = x0 * ALPHA + acc[ai][bj][m][0]; *(f32x4*)(out + idx + 4) = x1 * ALPHA + acc[ai][bj][m][1]; } }
        }
    }
};

namespace att {
constexpr int NW = 8, QBLK = 32, KVBLK = 64, QB = 256;
constexpr int SHM_V = KVBLK * DV * 2, SHM_K = KVBLK * DQK * 2;
constexpr int ATT_LDS = 2 * SHM_V + 2 * SHM_K + NW * 64 * 4;
constexpr float SCALE = 0.07216878364870322f;
constexpr float THR = 8.f;
#define KSWZ(row, colB) ((row) * 384 + ((colB) ^ (((row) & 7) << 4)))
#define SBAR() __builtin_amdgcn_sched_barrier(0)
__device__ __forceinline__ int v_st(int k, int c) { const int kk = (k & ~0xC) | ((k & 4) << 1) | ((k & 8) >> 1); return ((kk >> 3) * 4 + (c >> 5)) * 512 + ((kk & 7) * 32 + (c & 31)) * 2; }
__device__ __forceinline__ int v_rd_base(int lane) { return ((lane & 3) << 3) | (((lane >> 2) & 3) << 6) | (((lane >> 4) & 1) << 5) | (((lane >> 5) & 1) << 8); }
constexpr int v_rd_off(int d0, int ks, int half) { return d0 * 512 + ks * 4096 + half * 2048; }
__device__ __forceinline__ int crow(int r, int hi) { return (r & 3) + 8 * (r >> 2) + 4 * hi; }
__device__ __forceinline__ void mask_tile(f32x16& p0, f32x16& p1, int dq, unsigned W) {
    const float NEG = -__builtin_inff();
#pragma unroll
    for (int r = 0; r < 16; ++r) { const int c = (r & 3) + 8 * (r >> 2);
        if ((unsigned)(dq - c) >= W) p0[r] = NEG;
        if ((unsigned)(dq - c - 32) >= W) p1[r] = NEG; }
}
__device__ __forceinline__ void partialSM(f32x16& p0, f32x16& p1, float& m_reg, float& mn, float& alpha) {
    float pmax = p0[0];
#pragma unroll
    for (int r = 1; r < 16; ++r) pmax = fmaxf(pmax, p0[r]);
#pragma unroll
    for (int r = 0; r < 16; ++r) pmax = fmaxf(pmax, p1[r]);
    { auto rr = __builtin_amdgcn_permlane32_swap(__float_as_uint(pmax), __float_as_uint(pmax), false, false);
      pmax = fmaxf(__uint_as_float(rr[0]), __uint_as_float(rr[1])); }
    constexpr float C2 = 1.4426950408889634f * SCALE;
    if (__builtin_expect(__all((pmax - m_reg) * SCALE <= THR), 1)) { mn = m_reg; alpha = 1.f; }
    else { mn = fmaxf(m_reg, pmax); alpha = __builtin_amdgcn_exp2f((m_reg - mn) * C2); m_reg = mn; }
    const float mnL = -mn * C2;
#pragma unroll
    for (int r = 0; r < 16; ++r) p0[r] = fmaf(p0[r], C2, mnL);
#pragma unroll
    for (int r = 0; r < 16; ++r) p1[r] = fmaf(p1[r], C2, mnL);
#pragma unroll
    for (int r = 0; r < 16; ++r) p0[r] = __builtin_amdgcn_exp2f(p0[r]);
}
__device__ __forceinline__ void finishSM(f32x16& p0, f32x16& p1, float alpha, float& l_reg, bf16x8& pa0, bf16x8& pa1, bf16x8& pa2, bf16x8& pa3) {
#pragma unroll
    for (int r = 0; r < 16; ++r) p1[r] = __builtin_amdgcn_exp2f(p1[r]);
    float ps = 0;
#pragma unroll
    for (int r = 0; r < 16; ++r) ps += p0[r];
#pragma unroll
    for (int r = 0; r < 16; ++r) ps += p1[r];
    { auto rr = __builtin_amdgcn_permlane32_swap(__float_as_uint(ps), __float_as_uint(ps), false, false);
      ps = __uint_as_float(rr[0]) + __uint_as_float(rr[1]); }
    l_reg = l_reg * alpha + ps;
#define PK4(P_, B_, OUT) do { unsigned a0 = cvtpk(P_[B_+0], P_[B_+1]), a1 = cvtpk(P_[B_+2], P_[B_+3]);                          \
        unsigned b0 = cvtpk(P_[B_+4], P_[B_+5]), b1 = cvtpk(P_[B_+6], P_[B_+7]);                                             \
        auto r0 = __builtin_amdgcn_permlane32_swap(a0, b0, false, false); auto r1 = __builtin_amdgcn_permlane32_swap(a1, b1, false, false); \
        u32x4 w = {r0[0], r1[0], r0[1], r1[1]}; OUT = *reinterpret_cast<bf16x8*>(&w); } while (0)
    PK4(p0, 0, pa0); PK4(p0, 8, pa1); PK4(p1, 0, pa2); PK4(p1, 8, pa3);
#undef PK4
}
template <int KB>
__device__ __forceinline__ void qkt(f32x16& p0, f32x16& p1, const char* K_lds, int r32, int hi, const bf16x8* qr) {
    p0 = f32x16{}; p1 = f32x16{};
    const char* kb[4];
#pragma unroll
    for (int dd = 0; dd < 4; ++dd) kb[dd] = K_lds + KB * SHM_K + KSWZ(r32, (dd * 16 + hi * 8) * 2);
#pragma unroll
    for (int d0 = 0; d0 < 12; ++d0) { const char* a = kb[d0 & 3] + (d0 >> 2) * 128;
        bf16x8 b0 = *reinterpret_cast<const bf16x8*>(a);
        bf16x8 b1 = *reinterpret_cast<const bf16x8*>(a + 32 * 384);
        p0 = __builtin_amdgcn_mfma_f32_32x32x16_bf16(b0, qr[d0], p0, 0, 0, 0);
        p1 = __builtin_amdgcn_mfma_f32_32x32x16_bf16(b1, qr[d0], p1, 0, 0, 0); }
}
template <int VB>
__device__ __forceinline__ void pv_tile(f32x16* o, int vb0, bf16x8 pa0, bf16x8 pa1, bf16x8 pa2, bf16x8 pa3) {
#define TRRD(dst, off) asm volatile("ds_read_b64_tr_b16 %0, %1 offset:%2" : "=&v"(dst) : "v"(vb0), "i"(off) : "memory")
#define PV_D0(d0) do { s16x4 l0, l1, l2, l3, h0, h1, h2, h3; constexpr int b_ = VB * SHM_V + v_rd_off(d0, 0, 0);  \
        TRRD(l0, b_); TRRD(h0, b_ + 2048); TRRD(l1, b_ + 4096); TRRD(h1, b_ + 6144); TRRD(l2, b_ + 8192); TRRD(h2, b_ + 10240); TRRD(l3, b_ + 12288); TRRD(h3, b_ + 14336); \
        asm volatile("s_waitcnt lgkmcnt(0)" ::: "memory"); SBAR();   \
        o[d0] = __builtin_amdgcn_mfma_f32_32x32x16_bf16(pa0, (bf16x8){l0[0], l0[1], l0[2], l0[3], h0[0], h0[1], h0[2], h0[3]}, o[d0], 0, 0, 0);   \
        o[d0] = __builtin_amdgcn_mfma_f32_32x32x16_bf16(pa1, (bf16x8){l1[0], l1[1], l1[2], l1[3], h1[0], h1[1], h1[2], h1[3]}, o[d0], 0, 0, 0);   \
        o[d0] = __builtin_amdgcn_mfma_f32_32x32x16_bf16(pa2, (bf16x8){l2[0], l2[1], l2[2], l2[3], h2[0], h2[1], h2[2], h2[3]}, o[d0], 0, 0, 0);   \
        o[d0] = __builtin_amdgcn_mfma_f32_32x32x16_bf16(pa3, (bf16x8){l3[0], l3[1], l3[2], l3[3], h3[0], h3[1], h3[2], h3[3]}, o[d0], 0, 0, 0); } while (0)
    PV_D0(0); PV_D0(1); PV_D0(2); PV_D0(3);
#undef PV_D0
#undef TRRD
}
struct BlockRef { const bf16* Q; const bf16* K; const bf16* V; bf16* O; int P0; int t0, t1; float* part; const float* part_other; unsigned* flag; };
struct Seam { bf16x8 qr[12]; };
#define VMW() asm volatile("s_waitcnt vmcnt(0)" ::: "memory")
#define LD8(p) (*reinterpret_cast<const bf16x8*>(p))
#define DMA_DECL const int kp0 = wid * 64 + lane, kp1 = kp0 + 512, kp2 = kp0 + 1024; \
    const unsigned koff0 = (kp0 / 24) * 384 + (((kp0 % 24) ^ ((kp0 / 24) & 7)) << 4), koff1 = (kp1 / 24) * 384 + (((kp1 % 24) ^ ((kp1 / 24) & 7)) << 4), koff2 = (kp2 / 24) * 384 + (((kp2 % 24) ^ ((kp2 / 24) & 7)) << 4); \
    const unsigned voff0 = v_src(kp0), voff1 = v_src(kp0 + 512); \
    LAS unsigned char* lds3 = (LAS unsigned char*)lds
#define GLDS16(gp, ldsoff) __builtin_amdgcn_global_load_lds((const unsigned*)(gp), (LAS unsigned*)(lds3 + (ldsoff)), 16, 0, 0)
#define DMA_TILE(Kp, Vp, k0, bf) do { const char* kt_ = (const char*)((Kp) + (size_t)(k0) * DQK); const char* vt_ = (const char*)((Vp) + (size_t)(k0) * DV); \
        GLDS16(kt_ + koff0, 2 * SHM_V + (bf) * SHM_K + wid * 1024); GLDS16(kt_ + koff1, 2 * SHM_V + (bf) * SHM_K + (wid + 8) * 1024); GLDS16(kt_ + koff2, 2 * SHM_V + (bf) * SHM_K + (wid + 16) * 1024); \
        GLDS16(vt_ + voff0, (bf) * SHM_V + wid * 1024); GLDS16(vt_ + voff1, (bf) * SHM_V + (wid + 8) * 1024); } while (0)
__device__ __forceinline__ unsigned v_src(int q) {
    const int st = q >> 5, within = q & 31, kr = within >> 2, cch = within & 3, kk = (st >> 2) * 8 + kr;
    const int k = (kk & ~0xC) | ((kk & 4) << 1) | ((kk & 8) >> 1), c = (st & 3) * 32 + cch * 8;
    return (unsigned)(k * 256 + c * 2);
}
__device__ __forceinline__ void attn_prime(const BlockRef& cur, char* lds, Seam& S) {
    const int tid = threadIdx.x, wid = __builtin_amdgcn_readfirstlane(tid >> 6), lane = tid & 63, r32 = lane & 31, hi = lane >> 5;
    DMA_DECL;
    DMA_TILE(cur.K, cur.V, cur.t0 * KVBLK, 0);
#pragma unroll
    for (int d0 = 0; d0 < 12; ++d0) S.qr[d0] = LD8(cur.Q + (size_t)(wid * QBLK + r32) * DQK + d0 * 16 + hi * 8);
    VMW();
    __syncthreads();
}
__device__ __forceinline__ void attn_block(const BlockRef& cur, const BlockRef& nxt, char* lds, Seam& S) {
    const int tid = threadIdx.x, wid = __builtin_amdgcn_readfirstlane(tid >> 6), lane = tid & 63, r32 = lane & 31, hi = lane >> 5;
    const unsigned W = 1u << 30;
    const int T0 = cur.t0, T1 = cur.t1;
    const int qlo = cur.P0 + wid * QBLK, qm = qlo + r32 - 4 * hi;
    char* V_lds = lds; char* K_lds = lds + 2 * SHM_V;
    float* ws = (float*)(lds + 2 * SHM_V + 2 * SHM_K) + wid * 64; float* li_l = ws, * al_l = ws + 32;
    float m_reg = -1e30f, l_reg = 0; f32x16 o[4] = {};
    DMA_DECL;
    const int vb0 = (int)(uintptr_t)V_lds + v_rd_base(lane);
    const bf16* Kh = cur.K; const bf16* Vh = cur.V;
#define RESC(a) do { if (__any((a) < 1.f)) { if (hi == 0) al_l[r32] = (a); asm volatile("s_waitcnt lgkmcnt(0)" ::: "memory");              \
                     for (int d_ = 0; d_ < 4; ++d_) for (int r = 0; r < 16; ++r) o[d_][r] *= al_l[crow(r, hi)]; } } while (0)
#define KBASE(t) ((t) * KVBLK)
#define MASKT(P0_, P1_, t) do { const int kb_ = KBASE(t); if (kb_ + KVBLK - 1 > qlo) mask_tile(P0_, P1_, qm - kb_, W); } while (0)
    f32x16 p0, p1; float mn, al; bf16x8 pa0, pa1, pa2, pa3;
    for (int t = T0; t < T1; t += 2) {
        DMA_TILE(Kh, Vh, KBASE(t + 1), 1); SBAR();
        qkt<0>(p0, p1, K_lds, r32, hi, S.qr);
        MASKT(p0, p1, t); partialSM(p0, p1, m_reg, mn, al); finishSM(p0, p1, al, l_reg, pa0, pa1, pa2, pa3); RESC(al); SBAR();
        pv_tile<0>(o, vb0, pa0, pa1, pa2, pa3);
        VMW();
        __syncthreads();
        if (t + 2 < T1) { DMA_TILE(Kh, Vh, KBASE(t + 2), 0); } else { DMA_TILE(nxt.K, nxt.V, nxt.t0 * KVBLK, 0); } SBAR();
        qkt<1>(p0, p1, K_lds, r32, hi, S.qr); SBAR();
        MASKT(p0, p1, t + 1); partialSM(p0, p1, m_reg, mn, al); finishSM(p0, p1, al, l_reg, pa0, pa1, pa2, pa3); RESC(al); SBAR();
        pv_tile<1>(o, vb0, pa0, pa1, pa2, pa3);
        VMW();
        __syncthreads();
    }
    bf16* Ow = cur.O + (size_t)(wid * QBLK) * DM;
    if (cur.part == nullptr) {
        if (hi == 0) li_l[r32] = l_reg; asm volatile("s_waitcnt lgkmcnt(0)" ::: "memory");
        float rli[16];
#pragma unroll
        for (int r = 0; r < 16; ++r) rli[r] = __builtin_amdgcn_rcpf(li_l[crow(r, hi)]);
#pragma unroll
        for (int r = 0; r < 16; ++r) { const int orow = crow(r, hi);
#pragma unroll
            for (int d0 = 0; d0 < 4; ++d0) { const float v = o[d0][r] * rli[r];
                const float vn = __shfl_xor(v, 1);
                if ((r32 & 1) == 0) *(unsigned*)(Ow + (size_t)orow * DM + d0 * 32 + r32) = cvtpk(v, vn); } }
    } else {
        float* mine = cur.part + tid;
#pragma unroll
        for (int d0 = 0; d0 < 4; ++d0)
#pragma unroll
            for (int r = 0; r < 16; ++r) mine[(d0 * 16 + r) * 512] = o[d0][r];
        mine[32768] = m_reg; mine[32768 + 512] = l_reg;
        __threadfence();
        __syncthreads();
        unsigned* fbox = (unsigned*)(lds + ATT_LDS);
        if (tid == 0) { *fbox = atomicAdd(cur.flag, 1u); }
        __syncthreads();
        const unsigned old = *fbox;
        if (old == 1u) {
            __threadfence();
            const float* oth = cur.part_other + tid;
            constexpr float C2 = 1.4426950408889634f * SCALE;
            const float mo = __builtin_nontemporal_load(oth + 32768), lo = __builtin_nontemporal_load(oth + 32768 + 512);
            const float mm = fmaxf(m_reg, mo), fs = __builtin_amdgcn_exp2f((m_reg - mm) * C2), fo = __builtin_amdgcn_exp2f((mo - mm) * C2);
            const float il = 1.0f / (l_reg * fs + lo * fo);
            if (hi == 0) { li_l[r32] = fs * il; al_l[r32] = fo * il; }
            asm volatile("s_waitcnt lgkmcnt(0)" ::: "memory");
#pragma unroll
            for (int r = 0; r < 16; ++r) { const int orow = crow(r, hi); const float fa = li_l[orow], fb = al_l[orow];
#pragma unroll
                for (int d0 = 0; d0 < 4; ++d0) { const float v = o[d0][r] * fa + __builtin_nontemporal_load(oth + (d0 * 16 + r) * 512) * fb;
                    const float vn = __shfl_xor(v, 1);
                    if ((r32 & 1) == 0) *(unsigned*)(Ow + (size_t)orow * DM + d0 * 32 + r32) = cvtpk(v, vn); }
                if ((r & 3) == 3) asm volatile("" ::: "memory"); }
        }
        __syncthreads();
    }
#pragma unroll
    for (int d0 = 0; d0 < 12; ++d0) S.qr[d0] = LD8(nxt.Q + (size_t)(wid * QBLK + r32) * DQK + d0 * 16 + hi * 8);
#undef RESC
#undef KBASE
#undef MASKT
}
#undef VMW
#undef DMA_DECL
#undef GLDS16
#undef DMA_TILE
#undef LD8
}

struct Args {
    const float *x; const int* pos; const float *w_in, *q_g, *w_uq, *kv_g, *w_ukv, *conv_w, *w_out, *ln1_g, *ln1_b, *w_gu, *ffn_cw, *w_down, *ln2_g, *ln2_b;
    float* out; unsigned char* ws; int ph_lo, ph_hi;
};

__device__ __forceinline__ float wave_sum(float v) {
#pragma unroll
    for (int o = 1; o < 64; o <<= 1) v += __shfl_xor(v, o);
    return v;
}
__device__ __forceinline__ void transpose_item(const float* W, const float* g, int K, int N, bf16* WT, int k0, int n0, int dst_row0, LAS float* scr, int lane) {
#pragma unroll 8
    for (int i = 0; i < 32; ++i) { const int kk = 2 * i + (lane >> 5); float v = W[(size_t)(k0 + kk) * N + n0 + (lane & 31)]; if (g) v *= g[k0 + kk]; scr[kk * 33 + (lane & 31)] = v; }
    asm volatile("s_waitcnt lgkmcnt(0)" ::: "memory");
    const int c = lane & 7;
#pragma unroll
    for (int j = 0; j < 4; ++j) { const int n = (lane >> 3) + 8 * j; const LAS float* s = scr + (8 * c) * 33 + n;
        u32x4 o; o.x = cvtpk(s[0 * 33], s[1 * 33]); o.y = cvtpk(s[2 * 33], s[3 * 33]); o.z = cvtpk(s[4 * 33], s[5 * 33]); o.w = cvtpk(s[6 * 33], s[7 * 33]);
        *(u32x4*)(WT + (size_t)(dst_row0 + n) * K + k0 + 8 * c) = o; }
    asm volatile("s_waitcnt lgkmcnt(0)" ::: "memory");
}
__device__ __forceinline__ int map_win(int n0) {
    if (n0 < 768) return n0;
    if (n0 == 768) return 768;
    if (n0 == 800) return 896;
    if (n0 < 1856) return 1024 + (n0 - 832);
    if (n0 < 2880) { const int t = n0 - 1856; return 2048 + 256 * (t >> 7) + (t & 127); }
    { const int t = n0 - 2880; return 2048 + 256 * (t >> 7) + 128 + (t & 127); }
}
__device__ __forceinline__ int map_wuq(int n0) {
    const int h = n0 / 192, d = n0 % 192;
    if (d < 128) return h * 128 + d;
    if (d == 128) return 1024 + (h >> 2) * 256 + (h & 3) * 32;
    return 1024 + (h >> 2) * 256 + 128 + (h & 3) * 32;
}
__device__ __forceinline__ int map_wgu(int n0) {
    if (n0 < FF) return 256 * (n0 >> 7) + (n0 & 127);
    const int t = n0 - FF; return 256 * (t >> 7) + 128 + (t & 127);
}
__device__ __forceinline__ void sincos_acc(float x, float& s, float& c) {
    const double xd = (double)x;
    const double k = __builtin_rint(xd * 0.63661977236758134308);
    double r = __builtin_fma(-k, 1.57079632679489655800, xd); r = __builtin_fma(-k, 6.12323399573676603587e-17, r);
    const int q = ((int)k) & 3;
    const float rf = (float)r, r2 = rf * rf;
    const float sp = rf * (1.0f + r2 * (-1.6666667e-1f + r2 * (8.3333333e-3f + r2 * (-1.9841270e-4f + r2 * 2.7557319e-6f))));
    const float cp = 1.0f + r2 * (-0.5f + r2 * (4.1666667e-2f + r2 * (-1.3888889e-3f + r2 * (2.4801587e-5f + r2 * -2.7557319e-7f))));
    s = (q == 0) ? sp : (q == 1) ? cp : (q == 2) ? -sp : -cp;
    c = (q == 0) ? cp : (q == 1) ? -sp : (q == 2) ? -cp : sp;
}

__global__ void __launch_bounds__(NTHREADS, 2) mega_fwd(Args a) {
    extern __shared__ __attribute__((aligned(16))) unsigned char lds[];
    cg::grid_group grid = cg::this_grid();
    const int tid = threadIdx.x, lane = tid & 63, wave = __builtin_amdgcn_readfirstlane(tid >> 6);
    const int G = gridDim.x, bx = blockIdx.x;
    const int gw = bx * NWAVES + wave, NGW = G * NWAVES;
    unsigned char* ws = a.ws;
    float* ssq_q = (float*)(ws + WS_SSQQ); float* ssq_kv = (float*)(ws + WS_SSQKV); float* cs = (float*)(ws + WS_CS);
    bf16* Wd_t = (bf16*)(ws + WS_WD); bf16* Win_t = (bf16*)(ws + WS_WIN); bf16* Wuq_t = (bf16*)(ws + WS_WUQ); bf16* Wukv_t = (bf16*)(ws + WS_WUKV);
    bf16* Wout_t = (bf16*)(ws + WS_WOUT); bf16* Wgu_t = (bf16*)(ws + WS_WGU);
    bf16* X1b = (bf16*)(ws + WS_X1B); bf16* Xb = (bf16*)(ws + WS_XB); bf16* CQ = (bf16*)(ws + WS_CQ); bf16* CKV = (bf16*)(ws + WS_CKV);
    bf16* GBb = (bf16*)(ws + WS_GB); bf16* Pb = (bf16*)(ws + WS_P); bf16* Qb = (bf16*)(ws + WS_Q); bf16* Kb = (bf16*)(ws + WS_K); bf16* Vb = (bf16*)(ws + WS_V);
    bf16* MIX = (bf16*)(ws + WS_MIX); bf16* GU = (bf16*)(ws + WS_GU); bf16* ACT = (bf16*)(ws + WS_ACT);
    const int lo = a.ph_lo, hi_ = a.ph_hi;
#define IN(k) (lo <= (k) && (k) < hi_)
#define SEAM(k) do { if (IN(k) && IN((k) + 1)) grid.sync(); } while (0)
    Epi E; E.mode = 0; E.CQ = CQ; E.CKV = CKV; E.GB = GBb; E.P = Pb; E.Q = Qb; E.K = Kb; E.V = Vb; E.GU = GU; E.ssq_q = ssq_q; E.ssq_kv = ssq_kv; E.cs = cs; E.x = a.x; E.out = a.out;
    PG8_LAS unsigned char* ring = (PG8_LAS unsigned char*)lds;

    if (IN(0)) {
        LAS float* scr = (LAS float*)((LAS unsigned char*)lds + wave * 16384);
        constexpr int I0 = (DM / 64) * (NIN / 32), I1 = (QL / 64) * (1536 / 32), I2 = (KVL / 64) * (2048 / 32), I3 = (DM / 64) * (DM / 32), I4 = (DM / 64) * (NGU / 32), I5 = (FF / 64) * (DM / 32);
        constexpr int NIT = I0 + I1 + I2 + I3 + I4 + I5;
        for (int it = gw; it < NIT; it += NGW) {
            int r = it;
            if (r < I4) { const int nb = NGU / 32, kb = r / nb, n0 = (r % nb) * 32; transpose_item(a.w_gu, nullptr, DM, NGU, Wgu_t, kb * 64, n0, map_wgu(n0), scr, lane); continue; } r -= I4;
            if (r < I5) { const int nb = DM / 32, kb = r / nb, n0 = (r % nb) * 32; transpose_item(a.w_down, nullptr, FF, DM, Wd_t, kb * 64, n0, n0, scr, lane); continue; } r -= I5;
            if (r < I0) { const int nb = NIN / 32, kb = r / nb, n0 = (r % nb) * 32; transpose_item(a.w_in, nullptr, DM, NIN, Win_t, kb * 64, n0, map_win(n0), scr, lane); continue; } r -= I0;
            if (r < I3) { const int nb = DM / 32, kb = r / nb, n0 = (r % nb) * 32; transpose_item(a.w_out, nullptr, DM, DM, Wout_t, kb * 64, n0, n0, scr, lane); continue; } r -= I3;
            if (r < I1) { const int nb = 1536 / 32, kb = r / nb, n0 = (r % nb) * 32; transpose_item(a.w_uq, a.q_g, QL, 1536, Wuq_t, kb * 64, n0, map_wuq(n0), scr, lane); continue; } r -= I1;
            { const int nb = 2048 / 32, kb = r / nb, n0 = (r % nb) * 32; transpose_item(a.w_ukv, a.kv_g, KVL, 2048, Wukv_t, kb * 64, n0, n0, scr, lane); }
        }
        for (int rr = gw; rr < 192; rr += NGW) { const int row = rr < 96 ? 800 + rr : 928 + (rr - 96);
            u32x4* p = (u32x4*)(Win_t + (size_t)row * DM); const u32x4 z = {0u, 0u, 0u, 0u};
#pragma unroll
            for (int j = 0; j < 4; ++j) p[lane + 64 * j] = z; }
        for (int m = gw; m < M; m += NGW) { const f32x4* xr = (const f32x4*)(a.x + (size_t)m * DM); u32x4* o = (u32x4*)(Xb + (size_t)m * DM);
#pragma unroll
            for (int j = 0; j < 4; ++j) { const f32x4 v0 = xr[2 * (lane + 64 * j)], v1 = xr[2 * (lane + 64 * j) + 1]; o[lane + 64 * j] = pack8(v0, v1); } }
        for (int i = bx * NTHREADS + tid; i < M; i += G * NTHREADS) { ssq_q[i] = 0.f; ssq_kv[i] = 0.f; }
        if (bx == 0 && tid < 128) ((unsigned*)(ws + WS_AFLAG))[tid] = 0u;
        for (int i = bx * NTHREADS + tid; i < M * 32; i += G * NTHREADS) { const int row = i >> 5, f = i & 31;
            const float inv = (float)exp2(-(double)f * (13.287712379549449 / 32.0));
            const float ang = (float)a.pos[row] * inv; float s, c; sincos_acc(ang, s, c);
            cs[(size_t)row * 64 + f] = c; cs[(size_t)row * 64 + 32 + f] = s; }
    }
    SEAM(0);
    if (IN(1)) {
        pg8::Gemm g{Xb, Win_t, M, NINP, DM}; pg8::StaticOrder S; S.init(M, NINP, G, bx); E.mode = 1;
        pg8::gemm_phase<Epi, pg8::StaticOrder, true, true>(ring, g, S, E);
    }
    SEAM(1);
    if (IN(2)) {
        { pg8::Gemm g{CQ, Wuq_t, M, 1536, QL}; pg8::StaticOrder S; S.init(M, 1536, G, bx); E.mode = 2;
          pg8::gemm_phase<Epi, pg8::StaticOrder, true, true>(ring, g, S, E); }
        { pg8::Gemm g{CKV, Wukv_t, M, 2048, KVL}; pg8::StaticOrder S; S.init(M, 2048, G, bx); E.mode = 3;
          pg8::gemm_phase<Epi, pg8::StaticOrder, true, true>(ring, g, S, E); }
        { const int cc = tid & 127, rg = tid >> 7;
          float w0[8], w1[8], w2[8];
#pragma unroll
          for (int j = 0; j < 8; ++j) { w0[j] = a.conv_w[cc * 8 + j]; w1[j] = a.conv_w[CW + cc * 8 + j]; w2[j] = a.conv_w[2 * CW + cc * 8 + j]; }
          for (int it = bx; it < M / 32; it += G) {
              const int r0 = it * 32 + rg * 8;
              float pm2[8], pm1[8];
              if ((r0 & (SEQ - 1)) == 0) {
#pragma unroll
                  for (int j = 0; j < 8; ++j) { pm2[j] = 0.f; pm1[j] = 0.f; }
              } else { unpack8(*(const u32x4*)(Pb + (size_t)(r0 - 2) * CW + cc * 8), pm2); unpack8(*(const u32x4*)(Pb + (size_t)(r0 - 1) * CW + cc * 8), pm1); }
#pragma unroll
              for (int r = 0; r < 8; ++r) { float pc[8], gb[8], o[8];
                  unpack8(*(const u32x4*)(Pb + (size_t)(r0 + r) * CW + cc * 8), pc); unpack8(*(const u32x4*)(GBb + (size_t)(r0 + r) * CW + cc * 8), gb);
#pragma unroll
                  for (int j = 0; j < 8; ++j) { o[j] = gb[j] * (w2[j] * pc[j] + w1[j] * pm1[j] + w0[j] * pm2[j]); pm2[j] = pm1[j]; pm1[j] = pc[j]; }
                  u32x4 w = {cvtpk(o[0], o[1]), cvtpk(o[2], o[3]), cvtpk(o[4], o[5]), cvtpk(o[6], o[7])};
                  *(u32x4*)(MIX + (size_t)(r0 + r) * DM + CW + cc * 8) = w; }
          } }
    }
    SEAM(2);
    if (IN(3)) {
        float* PART = (float*)(ws + WS_PART); unsigned* AFLAG = (unsigned*)(ws + WS_AFLAG);
        constexpr int PSZ = 64 * 512 + 1024;
#pragma nounroll
        for (int uu = bx; uu < 256; uu += G) {
            const int xcd = uu & 7, idx = uu >> 3;
            const int bh = 2 * xcd + (idx >> 4), xq = (idx >> 1) & 7, role = idx & 1;
            const bf16* Qh = Qb + (size_t)bh * SEQ * DQK; const bf16* Kh = Kb + (size_t)bh * SEQ * DQK; const bf16* Vh = Vb + (size_t)bh * SEQ * DV;
            bf16* Oh = MIX + (size_t)(bh >> 3) * SEQ * DM + (bh & 7) * DV;
            const int hq = 15 - xq;
            float* pb = PART + (size_t)(bh * 8 + xq) * 2 * PSZ;
            att::BlockRef hb{Qh + (size_t)hq * 256 * DQK, Kh, Vh, Oh + (size_t)hq * 256 * DM, hq * 256, 0, 34, pb + role * PSZ, pb + (1 - role) * PSZ, AFLAG + bh * 8 + xq};
            att::Seam S;
            att::BlockRef cur = hb;
            if (role != 0) {
                hb.t0 = 34; hb.t1 = 4 * (hq + 1);
                cur = att::BlockRef{Qh + (size_t)xq * 256 * DQK, Kh, Vh, Oh + (size_t)xq * 256 * DM, xq * 256, 0, 4 * (xq + 1), nullptr, nullptr, nullptr};
            }
            att::attn_prime(cur, (char*)lds, S);
#pragma nounroll
            for (int i = 0; i <= role; ++i) { att::attn_block(cur, hb, (char*)lds, S); cur = hb; }
        }
    }
    SEAM(3);
    if (IN(4)) {
        pg8::Gemm g{MIX, Wout_t, M, DM, DM}; pg8::StaticOrder S; S.init(M, DM, G, bx); E.mode = 4;
        pg8::gemm_phase<Epi, pg8::StaticOrder, true, true>(ring, g, S, E);
    }
    SEAM(4);
    if (IN(5)) {
        for (int m = gw; m < M; m += NGW) {
            f32x4* xr = (f32x4*)(a.out + (size_t)m * DM) + lane; f32x4 v[8]; float s = 0.f;
#pragma unroll
            for (int j = 0; j < 8; ++j) { v[j] = xr[64 * j]; s += (v[j][0] + v[j][1]) + (v[j][2] + v[j][3]); }
            const float mean = wave_sum(s) * (1.f / DM); float s2 = 0.f;
#pragma unroll
            for (int j = 0; j < 8; ++j) { v[j] = v[j] - mean; s2 += (v[j][0] * v[j][0] + v[j][1] * v[j][1]) + (v[j][2] * v[j][2] + v[j][3] * v[j][3]); }
            const float rstd = 1.f / sqrtf(wave_sum(s2) * (1.f / DM) + LN_EPS);
            u32x2* ob = (u32x2*)(X1b + (size_t)m * DM) + lane;
#pragma unroll
            for (int j = 0; j < 8; ++j) { const f32x4 gg = ((const f32x4*)a.ln1_g)[lane + 64 * j], bb = ((const f32x4*)a.ln1_b)[lane + 64 * j];
                const f32x4 y = v[j] * rstd * gg + bb; xr[64 * j] = y; u32x2 w = {cvtpk(y[0], y[1]), cvtpk(y[2], y[3])}; ob[64 * j] = w; }
        }
    }
    SEAM(5);
    if (IN(6)) {
        pg8::Gemm g{X1b, Wgu_t, M, NGU, DM}; pg8::StaticOrder S; S.init(M, NGU, G, bx); E.mode = 5;
        pg8::gemm_phase<Epi, pg8::StaticOrder, true, true>(ring, g, S, E);
    }
    SEAM(6);
    if (IN(7)) {
        const int NCC = NGU / 16;
        const long total = (long)NCC * (M / 8);
        for (long uu = (long)bx * NTHREADS + tid; uu < total; uu += (long)G * NTHREADS) {
            const int cc = (int)(uu % NCC), rb = (int)(uu / NCC), r0 = rb * 8;
            const int j = cc >> 4, r8 = (cc & 15) * 8;
            const int cg_ = j * 128 + r8, cu_ = FF + cg_;
            const bf16* gp = GU + (size_t)j * 256 + r8; const bf16* up = gp + 128;
            float wg0[8], wg1[8], wg2[8], wu0[8], wu1[8], wu2[8];
#pragma unroll
            for (int q = 0; q < 8; ++q) { wg0[q] = a.ffn_cw[cg_ + q]; wg1[q] = a.ffn_cw[NGU + cg_ + q]; wg2[q] = a.ffn_cw[2 * NGU + cg_ + q];
                wu0[q] = a.ffn_cw[cu_ + q]; wu1[q] = a.ffn_cw[NGU + cu_ + q]; wu2[q] = a.ffn_cw[2 * NGU + cu_ + q]; }
            float g2[8], g1[8], u2[8], u1[8];
            if ((r0 & (SEQ - 1)) == 0) {
#pragma unroll
                for (int q = 0; q < 8; ++q) { g2[q] = 0.f; g1[q] = 0.f; u2[q] = 0.f; u1[q] = 0.f; }
            } else { unpack8(*(const u32x4*)(gp + (size_t)(r0 - 2) * NGU), g2); unpack8(*(const u32x4*)(gp + (size_t)(r0 - 1) * NGU), g1);
                     unpack8(*(const u32x4*)(up + (size_t)(r0 - 2) * NGU), u2); unpack8(*(const u32x4*)(up + (size_t)(r0 - 1) * NGU), u1); }
#pragma unroll
            for (int r = 0; r < 8; ++r) { float gc[8], uc[8], o[8];
                unpack8(*(const u32x4*)(gp + (size_t)(r0 + r) * NGU), gc); unpack8(*(const u32x4*)(up + (size_t)(r0 + r) * NGU), uc);
#pragma unroll
                for (int q = 0; q < 8; ++q) { const float gv = wg2[q] * gc[q] + wg1[q] * g1[q] + wg0[q] * g2[q], uv = wu2[q] * uc[q] + wu1[q] * u1[q] + wu0[q] * u2[q];
                    o[q] = gv / (1.f + __expf(-gv)) * uv; g2[q] = g1[q]; g1[q] = gc[q]; u2[q] = u1[q]; u1[q] = uc[q]; }
                u32x4 w = {cvtpk(o[0], o[1]), cvtpk(o[2], o[3]), cvtpk(o[4], o[5]), cvtpk(o[6], o[7])};
                *(u32x4*)(ACT + (size_t)(r0 + r) * FF + cg_) = w; }
        }
    }
    SEAM(7);
    if (IN(8)) {
        pg8::Gemm g{ACT, Wd_t, M, DM, FF}; pg8::StaticOrder S; S.init(M, DM, G, bx); E.mode = 6;
        pg8::gemm_phase<Epi, pg8::StaticOrder, true, true>(ring, g, S, E);
    }
    SEAM(8);
    if (IN(9)) {
        for (int m = gw; m < M; m += NGW) {
            f32x4* xr = (f32x4*)(a.out + (size_t)m * DM) + lane; f32x4 v[8]; float s = 0.f;
#pragma unroll
            for (int j = 0; j < 8; ++j) { v[j] = xr[64 * j]; s += (v[j][0] + v[j][1]) + (v[j][2] + v[j][3]); }
            const float mean = wave_sum(s) * (1.f / DM); float s2 = 0.f;
#pragma unroll
            for (int j = 0; j < 8; ++j) { v[j] = v[j] - mean; s2 += (v[j][0] * v[j][0] + v[j][1] * v[j][1]) + (v[j][2] * v[j][2] + v[j][3] * v[j][3]); }
            const float rstd = 1.f / sqrtf(wave_sum(s2) * (1.f / DM) + LN_EPS);
#pragma unroll
            for (int j = 0; j < 8; ++j) { const f32x4 gg = ((const f32x4*)a.ln2_g)[lane + 64 * j], bb = ((const f32x4*)a.ln2_b)[lane + 64 * j];
                xr[64 * j] = v[j] * rstd * gg + bb; }
        }
    }
#undef IN
#undef SEAM
}

#ifndef MK_PER_PHASE
#define MK_PER_PHASE 0
#endif
constexpr int NPHASE = 10;
extern "C" void kernel_launch(void* const* d_in, const int* in_sizes, int n_in, void* d_out, int out_size, void* d_ws, size_t ws_size, hipStream_t stream) {
    static int grid = 0;
    if (grid == 0) {
        if (n_in != 16 || in_sizes[0] != M * DM || out_size != M * DM || ws_size < WS_END) { fprintf(stderr, "kernel_launch: unexpected shapes (n_in %d, ws %zu)\n", n_in, ws_size); grid = -1; return; }
        int dev = 0, cus = 0, per_cu = 0;
        (void)hipGetDevice(&dev); (void)hipDeviceGetAttribute(&cus, hipDeviceAttributeMultiprocessorCount, dev);
        if (hipFuncSetAttribute((const void*)mega_fwd, hipFuncAttributeMaxDynamicSharedMemorySize, LDS_BYTES) != hipSuccess) { fprintf(stderr, "kernel_launch: hipFuncSetAttribute failed\n"); grid = -1; return; }
        if (hipOccupancyMaxActiveBlocksPerMultiprocessor(&per_cu, (const void*)mega_fwd, NTHREADS, LDS_BYTES) != hipSuccess || per_cu < 1) { fprintf(stderr, "kernel_launch: occupancy query says %d\n", per_cu); per_cu = 1; }
        (void)hipGetLastError();
        grid = cus > 0 ? cus : 256;
    }
    if (grid < 0) return;
    Args a{};
    a.x = (const float*)d_in[0]; a.pos = (const int*)d_in[1]; a.w_in = (const float*)d_in[2]; a.q_g = (const float*)d_in[3]; a.w_uq = (const float*)d_in[4];
    a.kv_g = (const float*)d_in[5]; a.w_ukv = (const float*)d_in[6]; a.conv_w = (const float*)d_in[7]; a.w_out = (const float*)d_in[8]; a.ln1_g = (const float*)d_in[9];
    a.ln1_b = (const float*)d_in[10]; a.w_gu = (const float*)d_in[11]; a.ffn_cw = (const float*)d_in[12]; a.w_down = (const float*)d_in[13]; a.ln2_g = (const float*)d_in[14]; a.ln2_b = (const float*)d_in[15];
    a.out = (float*)d_out; a.ws = (unsigned char*)d_ws;
#if MK_PER_PHASE
    for (int p = 0; p < NPHASE; ++p) { a.ph_lo = p; a.ph_hi = p + 1; hipLaunchKernelGGL(mega_fwd, dim3(grid), dim3(NTHREADS), LDS_BYTES, stream, a); }
#else
    a.ph_lo = 0; a.ph_hi = NPHASE;
    void* args[] = {&a};
    hipError_t e = hipLaunchCooperativeKernel((const void*)mega_fwd, dim3(grid), dim3(NTHREADS), args, LDS_BYTES, stream);
    if (e != hipSuccess) fprintf(stderr, "cooperative launch failed: %s (grid %d)\n", hipGetErrorString(e), grid);
#endif
}
```

```cpp
#include <hip/hip_runtime.h>
#include <hip/hip_cooperative_groups.h>
#include <cstdio>
#include <cstdint>
namespace cg = cooperative_groups;
namespace pg8 {
#define PG8_LAS __attribute__((address_space(3)))
typedef unsigned short bf16_t;
typedef short bf16x8 __attribute__((ext_vector_type(8)));
typedef float f32x4 __attribute__((ext_vector_type(4)));
typedef unsigned u32x4 __attribute__((ext_vector_type(4)));
constexpr int BM = 256, BK = 64, HALF = 128, HTB = HALF * BK * 2  , STAGE_BYTES = 8 * HTB, NXCD = 8, WGM = 8;

__host__ __device__ __forceinline__ int lds_byte(int r, int c) { const int st = (r >> 4) * 2 + (c >> 5), rr = r & 15, cc = c & 31, ob = rr * 64 + cc * 2; return st * 1024 + (ob ^ (((ob >> 9) & 1) << 5)); }
__host__ __device__ __forceinline__ void stage_rc(int b, int& R, int& C) { const int st = b / 1024, sb = b % 1024, swz = sb ^ (((sb >> 9) & 1) << 5); R = (st >> 1) * 16 + swz / 64; C = (st & 1) * 32 + (swz % 64) / 2; }
__host__ __device__ __forceinline__ int perm32(int rho) { const int n = rho >> 4, i = rho & 15; return 8 * (i >> 2) + 4 * n + (i & 3); }

struct Unit { int pm, pn; };
struct Gemm { const bf16_t* A; const bf16_t* Bt; int M, N, K; };

struct StaticOrder {
    int nM, nN, nwg, G, c;
    __host__ __device__ void init(int M, int N, int G_, int c_) { nM = M / BM; nN = N / BM; nwg = nM * nN; G = G_; c = c_; }
    __host__ __device__ bool next(int i, Unit& u) const {
        const long L = (long)i * G + c; if (L >= nwg) return false;
        int wgid = (int)L; { const int q = nwg / NXCD, r = nwg % NXCD, xcd = wgid % NXCD, off = wgid / NXCD; wgid = (xcd < r ? xcd * (q + 1) : r * (q + 1) + (xcd - r) * q) + off; }
        const int nig = WGM * nN, gid = wgid / nig, fm = gid * WGM, gsz = (nM - fm) < WGM ? (nM - fm) : WGM;
        u.pm = fm + ((wgid % nig) % gsz); u.pn = (wgid % nig) / gsz; return true;
    }
    __device__ __forceinline__ void a_ready(const Unit&) const {}
    __device__ __forceinline__ void done(const Unit&) const {}
};

__device__ __forceinline__ unsigned cvt_pk_bf16(float lo, float hi) { unsigned r; asm volatile("v_cvt_pk_bf16_f32 %0, %1, %2" : "=v"(r) : "v"(lo), "v"(hi)); return r; }
typedef float f32x2 __attribute__((ext_vector_type(2)));
template <class Epi, class Sched, bool ALIGN_EPI = false, bool SP2 = false>
__device__ __forceinline__ void gemm_phase(PG8_LAS unsigned char* lds, const Gemm g, const Sched& S, const Epi& E) {
    const int tid = threadIdx.x, wid = __builtin_amdgcn_readfirstlane(tid >> 6), lane = tid & 63, wr = wid >> 2, wc = wid & 3, fr = lane & 15, fq = lane >> 4;
    const int K = g.K, nt = K / BK;
    unsigned voffA[2], voffB[2];
#pragma unroll
    for (int i = 0; i < 2; ++i) { int R, C; stage_rc(tid * 16 + i * 8192, R, C); const int Rb = Epi::PERM ? ((R & ~31) + perm32(R & 31)) : R;
        voffA[i] = (unsigned)(R * K + C) * 2u; voffB[i] = (unsigned)(Rb * K + C) * 2u; }
    const size_t kstep = (size_t)(BK * 2);
    const size_t hstep = (size_t)HALF * K * 2;
    const size_t tstep = 2 * hstep;
    const unsigned ldsw = (unsigned)wid * 1024u;
    const int aoff = lds_byte(wr * 64 + fr, fq * 8), boff = lds_byte(wc * 32 + fr, fq * 8);
#define PG8_SA(b, h) (((b) * 2 + (h)) * HTB)
#define PG8_SB(b, h) ((4 + (b) * 2 + (h)) * HTB)
#define PG8_STAGE(bufoff, gbase, voff) do { _Pragma("unroll") for (int _i = 0; _i < 2; ++_i) \
        __builtin_amdgcn_global_load_lds((const unsigned*)((const char*)(gbase) + (voff)[_i]), (PG8_LAS unsigned*)(lds + (bufoff) + ldsw + _i * 8192), 16, 0, 0); } while (0)
#define PG8_LDA(dst, b, h) do { _Pragma("unroll") for (int m = 0; m < 4; ++m) _Pragma("unroll") for (int k = 0; k < 2; ++k) dst[m][k] = *(const PG8_LAS bf16x8*)(lds + PG8_SA(b, h) + aoff + m * 2048 + k * 1024); } while (0)
#define PG8_LDB(dst, b, h) do { _Pragma("unroll") for (int n = 0; n < 2; ++n) _Pragma("unroll") for (int k = 0; k < 2; ++k) dst[n][k] = *(const PG8_LAS bf16x8*)(lds + PG8_SB(b, h) + boff + n * 2048 + k * 1024); } while (0)
#define PG8_MMA(ai, bj, At, Bt) do { __builtin_amdgcn_s_setprio(1); _Pragma("unroll") for (int m = 0; m < 4; ++m) _Pragma("unroll") for (int n = 0; n < 2; ++n) _Pragma("unroll") for (int k = 0; k < 2; ++k) \
        acc[ai][bj][m][n] = __builtin_amdgcn_mfma_f32_16x16x32_bf16(Bt[n][k], At[m][k], acc[ai][bj][m][n], 0, 0, 0); __builtin_amdgcn_s_setprio(0); } while (0)
#define PG8_WAIT_V(n) asm volatile("s_waitcnt vmcnt(" #n ")" ::: "memory")
#define PG8_WAIT_L(n) asm volatile("s_waitcnt lgkmcnt(" #n ")" ::: "memory")
#define PG8_BAR __builtin_amdgcn_s_barrier()
#define PG8_SCHED __builtin_amdgcn_sched_barrier(0)
    Unit cur, nxt; int ui = 0;
    if (!S.next(0, cur)) return;
    f32x4 acc[2][2][4][2];
#pragma unroll
    for (int a = 0; a < 2; ++a)
#pragma unroll
        for (int b = 0; b < 2; ++b)
#pragma unroll
            for (int m = 0; m < 4; ++m)
#pragma unroll
                for (int n = 0; n < 2; ++n) acc[a][b][m][n] = (f32x4){0.f, 0.f, 0.f, 0.f};
    bf16x8 At[4][2], B0[2][2], B1[2][2];
    const char* cA = (const char*)g.A + (size_t)cur.pm * tstep; const char* cB = (const char*)g.Bt + (size_t)cur.pn * tstep;
    S.a_ready(cur);
    if constexpr (SP2) {
        PG8_STAGE(PG8_SB(0, 0), cB, voffB); PG8_STAGE(PG8_SB(0, 1), cB + hstep, voffB); PG8_STAGE(PG8_SA(0, 0), cA, voffA); PG8_STAGE(PG8_SA(0, 1), cA + hstep, voffA);
        if (wr == 1) PG8_BAR;
        PG8_WAIT_V(2); PG8_BAR;
        PG8_STAGE(PG8_SB(1, 0), cB + kstep, voffB); PG8_STAGE(PG8_SA(1, 0), cA + kstep, voffA); PG8_STAGE(PG8_SB(1, 1), cB + hstep + kstep, voffB);
        PG8_WAIT_V(6); PG8_BAR;
    } else {
        PG8_STAGE(PG8_SB(0, 0), cB, voffB); PG8_STAGE(PG8_SA(0, 0), cA, voffA); PG8_STAGE(PG8_SB(0, 1), cB + hstep, voffB); PG8_STAGE(PG8_SA(0, 1), cA + hstep, voffA);
        if (wr == 1) PG8_BAR;
        PG8_WAIT_V(4); PG8_BAR;
        PG8_STAGE(PG8_SB(1, 0), cB + kstep, voffB); PG8_STAGE(PG8_SA(1, 0), cA + kstep, voffA); PG8_STAGE(PG8_SB(1, 1), cB + hstep + kstep, voffB);
        PG8_WAIT_V(6); PG8_BAR;
    }
    for (;;) {
        const bool has_next = S.next(ui + 1, nxt);
        const char* nA = has_next ? (const char*)g.A + (size_t)nxt.pm * tstep : cA; const char* nB = has_next ? (const char*)g.Bt + (size_t)nxt.pn * tstep : cB;
        for (int t = 0; t < nt; t += 2) {
            const bool last = (t == nt - 2);
            const char* a1 = cA + (size_t)(t + 1) * kstep;
            const char* a2 = last ? nA : cA + (size_t)(t + 2) * kstep; const char* b2 = last ? nB : cB + (size_t)(t + 2) * kstep;
            const char* a3 = a2 + kstep; const char* b3 = b2 + kstep;
            if (last && has_next) S.a_ready(nxt);
            if constexpr (SP2) {
            PG8_LDB(B0, 0, 0); PG8_LDB(B1, 0, 1); PG8_SCHED; PG8_LDA(At, 0, 0); PG8_STAGE(PG8_SA(1, 1), a1 + hstep, voffA);
            PG8_WAIT_V(8); PG8_WAIT_L(0); PG8_BAR; PG8_MMA(0, 0, At, B0); PG8_MMA(0, 1, At, B1); PG8_BAR; PG8_SCHED;
            PG8_LDA(At, 0, 1); PG8_STAGE(PG8_SB(0, 0), b2, voffB); PG8_STAGE(PG8_SB(0, 1), b2 + hstep, voffB); PG8_STAGE(PG8_SA(0, 0), a2, voffA);
            PG8_WAIT_V(8); PG8_WAIT_L(0); PG8_BAR; PG8_MMA(1, 0, At, B0); PG8_MMA(1, 1, At, B1); PG8_BAR; PG8_SCHED;
            PG8_LDB(B0, 1, 0); PG8_LDB(B1, 1, 1); PG8_SCHED; PG8_LDA(At, 1, 0); PG8_STAGE(PG8_SA(0, 1), a2 + hstep, voffA);
            PG8_WAIT_V(8); PG8_WAIT_L(0); PG8_BAR; PG8_MMA(0, 0, At, B0); PG8_MMA(0, 1, At, B1); PG8_BAR; PG8_SCHED;
            PG8_LDA(At, 1, 1); PG8_STAGE(PG8_SB(1, 0), b3, voffB); PG8_STAGE(PG8_SB(1, 1), b3 + hstep, voffB); PG8_STAGE(PG8_SA(1, 0), a3, voffA);
            PG8_WAIT_V(8); PG8_WAIT_L(0); PG8_BAR; PG8_MMA(1, 0, At, B0); PG8_MMA(1, 1, At, B1); PG8_BAR; PG8_SCHED;
            } else {
            PG8_LDB(B0, 0, 0); PG8_SCHED; PG8_LDA(At, 0, 0); PG8_STAGE(PG8_SA(1, 1), a1 + hstep, voffA);
            PG8_WAIT_L(8); PG8_BAR; PG8_WAIT_L(0); PG8_MMA(0, 0, At, B0); PG8_BAR; PG8_SCHED;
            PG8_LDB(B1, 0, 1); PG8_STAGE(PG8_SB(0, 0), b2, voffB);
            PG8_BAR; PG8_WAIT_L(0); PG8_MMA(0, 1, At, B1); PG8_BAR;
            PG8_LDA(At, 0, 1); PG8_STAGE(PG8_SA(0, 0), a2, voffA);
            PG8_BAR; PG8_WAIT_L(0); PG8_MMA(1, 0, At, B0); PG8_BAR; PG8_SCHED;
            PG8_STAGE(PG8_SB(0, 1), b2 + hstep, voffB);
            PG8_WAIT_V(6); PG8_BAR; PG8_MMA(1, 1, At, B1); PG8_BAR;
            PG8_LDB(B0, 1, 0); PG8_SCHED; PG8_LDA(At, 1, 0); PG8_STAGE(PG8_SA(0, 1), a2 + hstep, voffA);
            PG8_WAIT_L(8); PG8_BAR; PG8_WAIT_L(0); PG8_MMA(0, 0, At, B0); PG8_BAR; PG8_SCHED;
            PG8_LDB(B1, 1, 1); PG8_STAGE(PG8_SB(1, 0), b3, voffB);
            PG8_BAR; PG8_WAIT_L(0); PG8_MMA(0, 1, At, B1); PG8_BAR;
            PG8_LDA(At, 1, 1); PG8_STAGE(PG8_SA(1, 0), a3, voffA);
            PG8_BAR; PG8_WAIT_L(0); PG8_MMA(1, 0, At, B0); PG8_BAR; PG8_SCHED;
            PG8_STAGE(PG8_SB(1, 1), b3 + hstep, voffB);
            PG8_WAIT_V(6); PG8_BAR; PG8_MMA(1, 1, At, B1); PG8_BAR;
            }
        }
        if constexpr (ALIGN_EPI) { if (wr == 0) PG8_BAR; }
        if constexpr (!Epi::AFTER_DRAIN) { E(acc, cur, wr, wc, fr, fq); S.done(cur); }
        if (!has_next) break;
#pragma unroll
        for (int a = 0; a < 2; ++a)
#pragma unroll
            for (int b = 0; b < 2; ++b)
#pragma unroll
                for (int m = 0; m < 4; ++m)
#pragma unroll
                    for (int n = 0; n < 2; ++n) acc[a][b][m][n] = (f32x4){0.f, 0.f, 0.f, 0.f};
        cur = nxt; cA = nA; cB = nB; ++ui;
        if constexpr (ALIGN_EPI) { if (wr == 1) PG8_BAR; }
    }
    PG8_WAIT_V(0);
    if constexpr (!ALIGN_EPI) { if (wr == 0) PG8_BAR; }
    PG8_BAR;
    if constexpr (Epi::AFTER_DRAIN) { E.fused(acc, cur, wr, wc, fr, fq, lds, wid, lane); S.done(cur); }
#undef PG8_SA
#undef PG8_SB
#undef PG8_STAGE
#undef PG8_LDA
#undef PG8_LDB
#undef PG8_MMA
#undef PG8_WAIT_V
#undef PG8_WAIT_L
#undef PG8_BAR
#undef PG8_SCHED
}
}
constexpr int SEQ = 4096, NBATCH = 2, M = NBATCH * SEQ, DM = 2048, NH = 8, DQK = 192, DV = 128;
constexpr int QL = 512, KVL = 256, CW = 1024, FF = 5632, NIN = 3904, NINP = 4096, NGU = 2 * FF;
constexpr float ALPHA = 1.189207115002721f;
constexpr float LN_EPS = 1e-5f, RMS_EPS = 1e-6f;

typedef unsigned short bf16;
typedef short bf16x8 __attribute__((ext_vector_type(8)));
typedef short s16x4 __attribute__((ext_vector_type(4)));
typedef float f32x4 __attribute__((ext_vector_type(4)));
typedef float f32x16 __attribute__((ext_vector_type(16)));
typedef unsigned u32x4 __attribute__((ext_vector_type(4)));
typedef unsigned u32x2 __attribute__((ext_vector_type(2)));
#define LAS __attribute__((address_space(3)))

constexpr size_t MiB = 1u << 20;
constexpr size_t WS_SSQQ = 0, WS_SSQKV = 64 * 1024;
constexpr size_t WS_CS = 1 * MiB;
constexpr size_t WS_WD = 3 * MiB, WS_WIN = 25 * MiB, WS_WUQ = 41 * MiB, WS_WUKV = 43 * MiB, WS_WOUT = 44 * MiB, WS_WGU = 52 * MiB;
constexpr size_t WS_X1B = 96 * MiB;
constexpr size_t WS_XB = 128 * MiB, WS_CQ = 160 * MiB, WS_CKV = 168 * MiB, WS_GB = 172 * MiB, WS_P = 188 * MiB;
constexpr size_t WS_Q = 204 * MiB, WS_K = 228 * MiB, WS_V = 252 * MiB, WS_MIX = 268 * MiB;
constexpr size_t WS_GU = 128 * MiB;
constexpr size_t WS_ACT = 25 * MiB;
constexpr size_t WS_PART = 304 * MiB;
constexpr size_t WS_BAR = 256 * 1024, WS_BAR_BYTES = 16 * 1024;
constexpr size_t WS_AFLAG = 128 * 1024;
constexpr size_t WS_END = 338 * MiB;

constexpr int NWAVES = 8, NTHREADS = 512;
constexpr int LDS_BYTES = 132096;

__device__ __forceinline__ unsigned cvtpk(float lo, float hi) { unsigned r; asm volatile("v_cvt_pk_bf16_f32 %0, %1, %2" : "=v"(r) : "v"(lo), "v"(hi)); return r; }
__device__ __forceinline__ u32x4 pack8(f32x4 a, f32x4 b) { u32x4 w = {cvtpk(a[0], a[1]), cvtpk(a[2], a[3]), cvtpk(b[0], b[1]), cvtpk(b[2], b[3])}; return w; }
__device__ __forceinline__ float bf2f(unsigned short h) { return __uint_as_float(((unsigned)h) << 16); }
__device__ __forceinline__ void unpack8(u32x4 w, float* f) {
#pragma unroll
    for (int i = 0; i < 4; ++i) { f[2 * i] = __uint_as_float(w[i] << 16); f[2 * i + 1] = __uint_as_float(w[i] & 0xffff0000u); }
}

struct Epi {
    static constexpr bool PERM = true, AFTER_DRAIN = false;
    int mode;
    bf16 *CQ, *CKV, *GB, *P, *Q, *K, *V, *GU;
    float *ssq_q, *ssq_kv; const float* cs; const float* x; float* out;
    __device__ __forceinline__ void operator()(const f32x4 (&acc)[2][2][4][2], const pg8::Unit& u, int wr, int wc, int fr, int fq) const {
        const int pn = u.pn, cb = wc * 32 + 8 * fq;
        const int rbase = u.pm * 256 + wr * 64 + fr;
        if (mode == 1) {
            if (pn < 3) {
#pragma unroll
                for (int ai = 0; ai < 2; ++ai)
#pragma unroll
                    for (int m = 0; m < 4; ++m) {
                        const int row = rbase + ai * 128 + m * 16;
                        bf16* dst = (pn < 2) ? (CQ + (size_t)row * QL + pn * 256) : (CKV + (size_t)row * KVL);
                        float ss = 0.f;
#pragma unroll
                        for (int bj = 0; bj < 2; ++bj) { const f32x4 v0 = acc[ai][bj][m][0], v1 = acc[ai][bj][m][1];
                            ss += (v0[0] * v0[0] + v0[1] * v0[1]) + (v0[2] * v0[2] + v0[3] * v0[3]) + (v1[0] * v1[0] + v1[1] * v1[1]) + (v1[2] * v1[2] + v1[3] * v1[3]);
                            *(u32x4*)(dst + bj * 128 + cb) = pack8(v0, v1); }
                        ss += __shfl_xor(ss, 16); ss += __shfl_xor(ss, 32);
                        if (fq == 0) atomicAdd(((pn < 2) ? ssq_q : ssq_kv) + row, ss);
                    }
            } else if (pn == 3) {
                if (wc == 0) {
#pragma unroll
                    for (int ai = 0; ai < 2; ++ai)
#pragma unroll
                        for (int m = 0; m < 4; ++m) {
                            const int row = rbase + ai * 128 + m * 16;
                            const float* c = cs + (size_t)row * 64 + 8 * fq;
                            const f32x4 c0 = *(const f32x4*)c, c1 = *(const f32x4*)(c + 4), s0 = *(const f32x4*)(c + 32), s1 = *(const f32x4*)(c + 36);
                            const f32x4 a0 = acc[ai][0][m][0], a1 = acc[ai][0][m][1], b0 = acc[ai][1][m][0], b1 = acc[ai][1][m][1];
                            const u32x4 o1 = pack8(a0 * c0 - b0 * s0, a1 * c1 - b1 * s1), o2 = pack8(a0 * s0 + b0 * c0, a1 * s1 + b1 * c1);
                            const int b = row >> 12, s_ = row & 4095;
#pragma unroll
                            for (int h = 0; h < NH; ++h) { bf16* kp = K + ((size_t)(b * NH + h) * SEQ + s_) * DQK + 128 + 8 * fq;
                                *(u32x4*)kp = o1; *(u32x4*)(kp + 32) = o2; }
                        }
                }
            } else if (pn < 8) {
#pragma unroll
                for (int ai = 0; ai < 2; ++ai)
#pragma unroll
                    for (int m = 0; m < 4; ++m) { const int row = rbase + ai * 128 + m * 16;
#pragma unroll
                        for (int bj = 0; bj < 2; ++bj) *(u32x4*)(GB + (size_t)row * CW + (pn - 4) * 256 + bj * 128 + cb) = pack8(acc[ai][bj][m][0], acc[ai][bj][m][1]); }
            } else {
#pragma unroll
                for (int ai = 0; ai < 2; ++ai)
#pragma unroll
                    for (int m = 0; m < 4; ++m) { const int row = rbase + ai * 128 + m * 16;
                        *(u32x4*)(P + (size_t)row * CW + (pn - 8) * 128 + cb) = pack8(acc[ai][0][m][0] * acc[ai][1][m][0], acc[ai][0][m][1] * acc[ai][1][m][1]); }
            }
        } else if (mode == 2) {
#pragma unroll
            for (int ai = 0; ai < 2; ++ai)
#pragma unroll
                for (int m = 0; m < 4; ++m) {
                    const int row = rbase + ai * 128 + m * 16; const int b = row >> 12, s_ = row & 4095;
                    const float rs = 1.0f / sqrtf(ssq_q[row] * (1.0f / QL) + RMS_EPS);
                    if (pn < 4) {
#pragma unroll
                        for (int bj = 0; bj < 2; ++bj) { const int head = 2 * pn + bj;
                            *(u32x4*)(Q + ((size_t)(b * NH + head) * SEQ + s_) * DQK + cb) = pack8(acc[ai][bj][m][0] * rs, acc[ai][bj][m][1] * rs); }
                    } else {
                        const int head = (pn - 4) * 4 + wc;
                        const float* c = cs + (size_t)row * 64 + 8 * fq;
                        const f32x4 c0 = *(const f32x4*)c, c1 = *(const f32x4*)(c + 4), s0 = *(const f32x4*)(c + 32), s1 = *(const f32x4*)(c + 36);
                        const f32x4 a0 = acc[ai][0][m][0] * rs, a1 = acc[ai][0][m][1] * rs, b0 = acc[ai][1][m][0] * rs, b1 = acc[ai][1][m][1] * rs;
                        bf16* qp = Q + ((size_t)(b * NH + head) * SEQ + s_) * DQK + 128 + 8 * fq;
                        *(u32x4*)qp = pack8(a0 * c0 - b0 * s0, a1 * c1 - b1 * s1); *(u32x4*)(qp + 32) = pack8(a0 * s0 + b0 * c0, a1 * s1 + b1 * c1);
                    }
                }
        } else if (mode == 3) {
#pragma unroll
            for (int ai = 0; ai < 2; ++ai)
#pragma unroll
                for (int m = 0; m < 4; ++m) {
                    const int row = rbase + ai * 128 + m * 16; const int b = row >> 12, s_ = row & 4095;
                    const float rs = 1.0f / sqrtf(ssq_kv[row] * (1.0f / KVL) + RMS_EPS);
                    const size_t tok = (size_t)(b * NH + pn) * SEQ + s_;
                    *(u32x4*)(K + tok * DQK + cb) = pack8(acc[ai][0][m][0] * rs, acc[ai][0][m][1] * rs);
                    *(u32x4*)(V + tok * DV + cb) = pack8(acc[ai][1][m][0] * rs, acc[ai][1][m][1] * rs);
                }
        } else if (mode == 4) {
#pragma unroll
            for (int ai = 0; ai < 2; ++ai)
#pragma unroll
                for (int m = 0; m < 4; ++m) { const int row = rbase + ai * 128 + m * 16;
#pragma unroll
                    for (int bj = 0; bj < 2; ++bj) { const size_t idx = (size_t)row * DM + pn * 256 + bj * 128 + cb;
                        const f32x4 x0 = *(const f32x4*)(x + idx), x1 = *(const f32x4*)(x + idx + 4);
                        *(f32x4*)(out + idx) = x0 * ALPHA + acc[ai][bj][m][0]; *(f32x4*)(out + idx + 4) = x1 * ALPHA + acc[ai][bj][m][1]; } }
        } else if (mode == 5) {
#pragma unroll
            for (int ai = 0; ai < 2; ++ai)
#pragma unroll
                for (int m = 0; m < 4; ++m) { const int row = rbase + ai * 128 + m * 16;
#pragma unroll
                    for (int bj = 0; bj < 2; ++bj) *(u32x4*)(GU + (size_t)row * NGU + pn * 256 + bj * 128 + cb) = pack8(acc[ai][bj][m][0], acc[ai][bj][m][1]); }
        } else {
#pragma unroll
            for (int ai = 0; ai < 2; ++ai)
#pragma unroll
                for (int m = 0; m < 4; ++m) { const int row = rbase + ai * 128 + m * 16;
#pragma unroll
                    for (int bj = 0; bj < 2; ++bj) { const size_t idx = (size_t)row * DM + pn * 256 + bj * 128 + cb;
                        const f32x4 x0 = *(const f32x4*)(out + idx), x1 = *(const f32x4*)(out + idx + 4);
                        *(f32x4*)(out + idx) = x0 * ALPHA + acc[ai][bj][m][0]; *(f32x4*)(out + idx + 4) = x1 * ALPHA + acc[ai][bj][m][1]; } }
        }
    }
};

namespace att {
constexpr int NW = 8, QBLK = 32, KVBLK = 64, QB = 256;
constexpr int SHM_V = KVBLK * DV * 2, SHM_K = KVBLK * DQK * 2;
constexpr int ATT_LDS = 2 * SHM_V + 2 * SHM_K + NW * 64 * 4;
constexpr float SCALE = 0.07216878364870322f;
constexpr float THR = 8.f;
#define KSWZ(row, colB) ((row) * 384 + ((colB) ^ (((row) & 7) << 4)))
#define SBAR() __builtin_amdgcn_sched_barrier(0)
__device__ __forceinline__ int v_st(int k, int c) { const int kk = (k & ~0xC) | ((k & 4) << 1) | ((k & 8) >> 1); return ((kk >> 3) * 4 + (c >> 5)) * 512 + ((kk & 7) * 32 + (c & 31)) * 2; }
__device__ __forceinline__ int v_rd_base(int lane) { return ((lane & 3) << 3) | (((lane >> 2) & 3) << 6) | (((lane >> 4) & 1) << 5) | (((lane >> 5) & 1) << 8); }
constexpr int v_rd_off(int d0, int ks, int half) { return d0 * 512 + ks * 4096 + half * 2048; }
__device__ __forceinline__ int crow(int r, int hi) { return (r & 3) + 8 * (r >> 2) + 4 * hi; }
__device__ __forceinline__ void mask_tile(f32x16& p0, f32x16& p1, int dq, unsigned W) {
    const float NEG = -__builtin_inff();
#pragma unroll
    for (int r = 0; r < 16; ++r) { const int c = (r & 3) + 8 * (r >> 2);
        if ((unsigned)(dq - c) >= W) p0[r] = NEG;
        if ((unsigned)(dq - c - 32) >= W) p1[r] = NEG; }
}
__device__ __forceinline__ void partialSM(f32x16& p0, f32x16& p1, float& m_reg, float& mn, float& alpha) {
    float pmax = p0[0];
#pragma unroll
    for (int r = 1; r < 16; ++r) pmax = fmaxf(pmax, p0[r]);
#pragma unroll
    for (int r = 0; r < 16; ++r) pmax = fmaxf(pmax, p1[r]);
    { auto rr = __builtin_amdgcn_permlane32_swap(__float_as_uint(pmax), __float_as_uint(pmax), false, false);
      pmax = fmaxf(__uint_as_float(rr[0]), __uint_as_float(rr[1])); }
    constexpr float C2 = 1.4426950408889634f * SCALE;
    if (__builtin_expect(__all((pmax - m_reg) * SCALE <= THR), 1)) { mn = m_reg; alpha = 1.f; }
    else { mn = fmaxf(m_reg, pmax); alpha = __builtin_amdgcn_exp2f((m_reg - mn) * C2); m_reg = mn; }
    const float mnL = -mn * C2;
#pragma unroll
    for (int r = 0; r < 16; ++r) p0[r] = fmaf(p0[r], C2, mnL);
#pragma unroll
    for (int r = 0; r < 16; ++r) p1[r] = fmaf(p1[r], C2, mnL);
#pragma unroll
    for (int r = 0; r < 16; ++r) p0[r] = __builtin_amdgcn_exp2f(p0[r]);
}
__device__ __forceinline__ void finishSM(f32x16& p0, f32x16& p1, float alpha, float& l_reg, bf16x8& pa0, bf16x8& pa1, bf16x8& pa2, bf16x8& pa3) {
#pragma unroll
    for (int r = 0; r < 16; ++r) p1[r] = __builtin_amdgcn_exp2f(p1[r]);
    float ps = 0;
#pragma unroll
    for (int r = 0; r < 16; ++r) ps += p0[r];
#pragma unroll
    for (int r = 0; r < 16; ++r) ps += p1[r];
    { auto rr = __builtin_amdgcn_permlane32_swap(__float_as_uint(ps), __float_as_uint(ps), false, false);
      ps = __uint_as_float(rr[0]) + __uint_as_float(rr[1]); }
    l_reg = l_reg * alpha + ps;
#define PK4(P_, B_, OUT) do { unsigned a0 = cvtpk(P_[B_+0], P_[B_+1]), a1 = cvtpk(P_[B_+2], P_[B_+3]);                          \
        unsigned b0 = cvtpk(P_[B_+4], P_[B_+5]), b1 = cvtpk(P_[B_+6], P_[B_+7]);                                             \
        auto r0 = __builtin_amdgcn_permlane32_swap(a0, b0, false, false); auto r1 = __builtin_amdgcn_permlane32_swap(a1, b1, false, false); \
        u32x4 w = {r0[0], r1[0], r0[1], r1[1]}; OUT = *reinterpret_cast<bf16x8*>(&w); } while (0)
    PK4(p0, 0, pa0); PK4(p0, 8, pa1); PK4(p1, 0, pa2); PK4(p1, 8, pa3);
#undef PK4
}
template <int KB>
__device__ __forceinline__ void qkt(f32x16& p0, f32x16& p1, const char* K_lds, int r32, int hi, const bf16x8* qr) {
    p0 = f32x16{}; p1 = f32x16{};
    const char* kb[4];
#pragma unroll
    for (int dd = 0; dd < 4; ++dd) kb[dd] = K_lds + KB * SHM_K + KSWZ(r32, (dd * 16 + hi * 8) * 2);
#pragma unroll
    for (int d0 = 0; d0 < 12; ++d0) { const char* a = kb[d0 & 3] + (d0 >> 2) * 128;
        bf16x8 b0 = *reinterpret_cast<const bf16x8*>(a);
        bf16x8 b1 = *reinterpret_cast<const bf16x8*>(a + 32 * 384);
        p0 = __builtin_amdgcn_mfma_f32_32x32x16_bf16(b0, qr[d0], p0, 0, 0, 0);
        p1 = __builtin_amdgcn_mfma_f32_32x32x16_bf16(b1, qr[d0], p1, 0, 0, 0); }
}
template <int VB>
__device__ __forceinline__ void pv_tile(f32x16* o, int vb0, bf16x8 pa0, bf16x8 pa1, bf16x8 pa2, bf16x8 pa3) {
#define TRRD(dst, off) asm volatile("ds_read_b64_tr_b16 %0, %1 offset:%2" : "=&v"(dst) : "v"(vb0), "i"(off) : "memory")
#define PV_D0(d0) do { s16x4 l0, l1, l2, l3, h0, h1, h2, h3; constexpr int b_ = VB * SHM_V + v_rd_off(d0, 0, 0);  \
        TRRD(l0, b_); TRRD(h0, b_ + 2048); TRRD(l1, b_ + 4096); TRRD(h1, b_ + 6144); TRRD(l2, b_ + 8192); TRRD(h2, b_ + 10240); TRRD(l3, b_ + 12288); TRRD(h3, b_ + 14336); \
        asm volatile("s_waitcnt lgkmcnt(0)" ::: "memory"); SBAR();   \
        o[d0] = __builtin_amdgcn_mfma_f32_32x32x16_bf16(pa0, (bf16x8){l0[0], l0[1], l0[2], l0[3], h0[0], h0[1], h0[2], h0[3]}, o[d0], 0, 0, 0);   \
        o[d0] = __builtin_amdgcn_mfma_f32_32x32x16_bf16(pa1, (bf16x8){l1[0], l1[1], l1[2], l1[3], h1[0], h1[1], h1[2], h1[3]}, o[d0], 0, 0, 0);   \
        o[d0] = __builtin_amdgcn_mfma_f32_32x32x16_bf16(pa2, (bf16x8){l2[0], l2[1], l2[2], l2[3], h2[0], h2[1], h2[2], h2[3]}, o[d0], 0, 0, 0);   \
        o[d0] = __builtin_amdgcn_mfma_f32_32x32x16_bf16(pa3, (bf16x8){l3[0], l3[1], l3[2], l3[3], h3[0], h3[1], h3[2], h3[3]}, o[d0], 0, 0, 0); } while (0)
    PV_D0(0); PV_D0(1); PV_D0(2); PV_D0(3);
#undef PV_D0
#undef TRRD
}
struct BlockRef { const bf16* Q; const bf16* K; const bf16* V; bf16* O; int P0; int t0, t1; float* part; const float* part_other; unsigned* flag; };
struct Seam { bf16x8 qr[12]; };
#define VMW() asm volatile("s_waitcnt vmcnt(0)" ::: "memory")
#define LD8(p) (*reinterpret_cast<const bf16x8*>(p))
#define DMA_DECL const int kp0 = wid * 64 + lane, kp1 = kp0 + 512, kp2 = kp0 + 1024; \
    const unsigned koff0 = (kp0 / 24) * 384 + (((kp0 % 24) ^ ((kp0 / 24) & 7)) << 4), koff1 = (kp1 / 24) * 384 + (((kp1 % 24) ^ ((kp1 / 24) & 7)) << 4), koff2 = (kp2 / 24) * 384 + (((kp2 % 24) ^ ((kp2 / 24) & 7)) << 4); \
    const unsigned voff0 = v_src(kp0), voff1 = v_src(kp0 + 512); \
    LAS unsigned char* lds3 = (LAS unsigned char*)lds
#define GLDS16(gp, ldsoff) __builtin_amdgcn_global_load_lds((const unsigned*)(gp), (LAS unsigned*)(lds3 + (ldsoff)), 16, 0, 0)
#define DMA_TILE(Kp, Vp, k0, bf) do { const char* kt_ = (const char*)((Kp) + (size_t)(k0) * DQK); const char* vt_ = (const char*)((Vp) + (size_t)(k0) * DV); \
        GLDS16(kt_ + koff0, 2 * SHM_V + (bf) * SHM_K + wid * 1024); GLDS16(kt_ + koff1, 2 * SHM_V + (bf) * SHM_K + (wid + 8) * 1024); GLDS16(kt_ + koff2, 2 * SHM_V + (bf) * SHM_K + (wid + 16) * 1024); \
        GLDS16(vt_ + voff0, (bf) * SHM_V + wid * 1024); GLDS16(vt_ + voff1, (bf) * SHM_V + (wid + 8) * 1024); } while (0)
__device__ __forceinline__ unsigned v_src(int q) {
    const int st = q >> 5, within = q & 31, kr = within >> 2, cch = within & 3, kk = (st >> 2) * 8 + kr;
    const int k = (kk & ~0xC) | ((kk & 4) << 1) | ((kk & 8) >> 1), c = (st & 3) * 32 + cch * 8;
    return (unsigned)(k * 256 + c * 2);
}
__device__ __forceinline__ void attn_prime(const BlockRef& cur, char* lds, Seam& S) {
    const int tid = threadIdx.x, wid = __builtin_amdgcn_readfirstlane(tid >> 6), lane = tid & 63, r32 = lane & 31, hi = lane >> 5;
    DMA_DECL;
    DMA_TILE(cur.K, cur.V, cur.t0 * KVBLK, 0);
#pragma unroll
    for (int d0 = 0; d0 < 12; ++d0) S.qr[d0] = LD8(cur.Q + (size_t)(wid * QBLK + r32) * DQK + d0 * 16 + hi * 8);
    VMW();
    __syncthreads();
}
__device__ __forceinline__ void attn_block(const BlockRef& cur, const BlockRef& nxt, char* lds, Seam& S) {
    const int tid = threadIdx.x, wid = __builtin_amdgcn_readfirstlane(tid >> 6), lane = tid & 63, r32 = lane & 31, hi = lane >> 5;
    const unsigned W = 1u << 30;
    const int T0 = cur.t0, T1 = cur.t1;
    const int qlo = cur.P0 + wid * QBLK, qm = qlo + r32 - 4 * hi;
    char* V_lds = lds; char* K_lds = lds + 2 * SHM_V;
    float* ws = (float*)(lds + 2 * SHM_V + 2 * SHM_K) + wid * 64; float* li_l = ws, * al_l = ws + 32;
    float m_reg = -1e30f, l_reg = 0; f32x16 o[4] = {};
    DMA_DECL;
    const int vb0 = (int)(uintptr_t)V_lds + v_rd_base(lane);
    const bf16* Kh = cur.K; const bf16* Vh = cur.V;
#define RESC(a) do { if (__any((a) < 1.f)) { if (hi == 0) al_l[r32] = (a); asm volatile("s_waitcnt lgkmcnt(0)" ::: "memory");              \
                     for (int d_ = 0; d_ < 4; ++d_) for (int r = 0; r < 16; ++r) o[d_][r] *= al_l[crow(r, hi)]; } } while (0)
#define KBASE(t) ((t) * KVBLK)
#define MASKT(P0_, P1_, t) do { const int kb_ = KBASE(t); if (kb_ + KVBLK - 1 > qlo) mask_tile(P0_, P1_, qm - kb_, W); } while (0)
    f32x16 p0, p1; float mn, al; bf16x8 pa0, pa1, pa2, pa3;
    for (int t = T0; t < T1; t += 2) {
        DMA_TILE(Kh, Vh, KBASE(t + 1), 1); SBAR();
        qkt<0>(p0, p1, K_lds, r32, hi, S.qr);
        MASKT(p0, p1, t); partialSM(p0, p1, m_reg, mn, al); finishSM(p0, p1, al, l_reg, pa0, pa1, pa2, pa3); RESC(al); SBAR();
        pv_tile<0>(o, vb0, pa0, pa1, pa2, pa3);
        VMW();
        __syncthreads();
        if (t + 2 < T1) { DMA_TILE(Kh, Vh, KBASE(t + 2), 0); } else { DMA_TILE(nxt.K, nxt.V, nxt.t0 * KVBLK, 0); } SBAR();
        qkt<1>(p0, p1, K_lds, r32, hi, S.qr); SBAR();
        MASKT(p0, p1, t + 1); partialSM(p0, p1, m_reg, mn, al); finishSM(p0, p1, al, l_reg, pa0, pa1, pa2, pa3); RESC(al); SBAR();
        pv_tile<1>(o, vb0, pa0, pa1, pa2, pa3);
        VMW();
        __syncthreads();
    }
    bf16* Ow = cur.O + (size_t)(wid * QBLK) * DM;
    if (cur.part == nullptr) {
        if (hi == 0) li_l[r32] = l_reg; asm volatile("s_waitcnt lgkmcnt(0)" ::: "memory");
        float rli[16];
#pragma unroll
        for (int r = 0; r < 16; ++r) rli[r] = __builtin_amdgcn_rcpf(li_l[crow(r, hi)]);
#pragma unroll
        for (int r = 0; r < 16; ++r) { const int orow = crow(r, hi);
#pragma unroll
            for (int d0 = 0; d0 < 4; ++d0) { const float v = o[d0][r] * rli[r];
                const float vn = __shfl_xor(v, 1);
                if ((r32 & 1) == 0) *(unsigned*)(Ow + (size_t)orow * DM + d0 * 32 + r32) = cvtpk(v, vn); } }
    } else {
        float* mine = cur.part + tid;
#pragma unroll
        for (int d0 = 0; d0 < 4; ++d0)
#pragma unroll
            for (int r = 0; r < 16; ++r) mine[(d0 * 16 + r) * 512] = o[d0][r];
        mine[32768] = m_reg; mine[32768 + 512] = l_reg;
        __threadfence();
        __syncthreads();
        unsigned* fbox = (unsigned*)(lds + ATT_LDS);
        if (tid == 0) { *fbox = atomicAdd(cur.flag, 1u); }
        __syncthreads();
        const unsigned old = *fbox;
        if (old == 1u) {
            __threadfence();
            const float* oth = cur.part_other + tid;
            constexpr float C2 = 1.4426950408889634f * SCALE;
            const float mo = __builtin_nontemporal_load(oth + 32768), lo = __builtin_nontemporal_load(oth + 32768 + 512);
            const float mm = fmaxf(m_reg, mo), fs = __builtin_amdgcn_exp2f((m_reg - mm) * C2), fo = __builtin_amdgcn_exp2f((mo - mm) * C2);
            const float il = 1.0f / (l_reg * fs + lo * fo);
            if (hi == 0) { li_l[r32] = fs * il; al_l[r32] = fo * il; }
            asm volatile("s_waitcnt lgkmcnt(0)" ::: "memory");
#pragma unroll
            for (int r = 0; r < 16; ++r) { const int orow = crow(r, hi); const float fa = li_l[orow], fb = al_l[orow];
#pragma unroll
                for (int d0 = 0; d0 < 4; ++d0) { const float v = o[d0][r] * fa + __builtin_nontemporal_load(oth + (d0 * 16 + r) * 512) * fb;
                    const float vn = __shfl_xor(v, 1);
                    if ((r32 & 1) == 0) *(unsigned*)(Ow + (size_t)orow * DM + d0 * 32 + r32) = cvtpk(v, vn); }
                if ((r & 3) == 3) asm volatile("" ::: "memory"); }
        }
        __syncthreads();
    }
#pragma unroll
    for (int d0 = 0; d0 < 12; ++d0) S.qr[d0] = LD8(nxt.Q + (size_t)(wid * QBLK + r32) * DQK + d0 * 16 + hi * 8);
#undef RESC
#undef KBASE
#undef MASKT
}
#undef VMW
#undef DMA_DECL
#undef GLDS16
#undef DMA_TILE
#undef LD8
}

#define XB_TMO      128
#define XB_XCNT(j)  (256  + 64 * (j))
#define XB_XSUB(j)  (1280 + 64 * (j))
#define XB_XGEN(j)  (2304 + 64 * (j))
#define XB_TOP      3328
#define XB_TOPGEN   3392
#define XCD_BAR_WORDS 3456
#define XB_SPIN_CAP (1u << 18)

__device__ __forceinline__ unsigned xb_ld(unsigned* p)              { return __hip_atomic_load(p, __ATOMIC_RELAXED, __HIP_MEMORY_SCOPE_AGENT); }
__device__ __forceinline__ unsigned xb_add(unsigned* p, unsigned v) { return __hip_atomic_fetch_add(p, v, __ATOMIC_RELAXED, __HIP_MEMORY_SCOPE_AGENT); }
__device__ __forceinline__ unsigned xb_xcc_id() { return (unsigned)__builtin_amdgcn_s_getreg((3 << 11) | 20) & 0xFu; }
#define XB_SPIN(cond, bar) do { unsigned _sp = 0; while (cond) { __builtin_amdgcn_s_sleep(1); \
    if ((++_sp & 255u) == 0u) { if (xb_ld(&(bar)[XB_TMO])) break; if (_sp > XB_SPIN_CAP) { atomicAdd(&(bar)[XB_TMO], 1u); break; } } } } while (0)

struct XcdBarrier {
    unsigned* bar; unsigned x;
    volatile LAS unsigned* st;
};

__device__ __forceinline__ XcdBarrier xcd_barrier_post(unsigned* bar, volatile LAS unsigned* st) {
    XcdBarrier b; b.bar = bar; b.x = xb_xcc_id(); b.st = st;
    if (threadIdx.x == 0) (void)xb_add(&bar[XB_XCNT(b.x)], 1u);
    return b;
}
__device__ __forceinline__ void xcd_barrier_complete(unsigned* bar, unsigned x, unsigned& nloc, unsigned& nx) {
    const unsigned G = gridDim.x * gridDim.y * gridDim.z;
    unsigned sum, cnt, mine, sp = 0u;
    for (;;) {
        sum = 0u; cnt = 0u; mine = 0u;
#pragma unroll
        for (unsigned j = 0; j < 16; ++j) { const unsigned c = xb_ld(&bar[XB_XCNT(j)]); sum += c; cnt += (c > 0u) ? 1u : 0u; mine = (j == x) ? c : mine; }
        if (sum == G) break;
        __builtin_amdgcn_s_sleep(1);
        if ((++sp & 255u) == 0u) { if (xb_ld(&bar[XB_TMO])) break; if (sp > XB_SPIN_CAP) { atomicAdd(&bar[XB_TMO], 1u); break; } }
    }
    nloc = mine > 0u ? mine : 1u; nx = cnt > 0u ? cnt : 1u;
}

__device__ __forceinline__ void xcd_barrier(const XcdBarrier& b) {
    asm volatile("s_waitcnt vmcnt(0)" ::: "memory");
    __syncthreads();
    if (threadIdx.x == 0) {
        unsigned* bar = b.bar;
        __builtin_amdgcn_s_waitcnt(0);
        unsigned nloc = b.st[0], nx = b.st[1];
        if (nloc == 0u) { xcd_barrier_complete(bar, b.x, nloc, nx); b.st[0] = nloc; b.st[1] = nx; }
        const unsigned old = xb_add(&bar[XB_XSUB(b.x)], 1u);
        const unsigned gen = old / nloc;
        if (old + 1u == (gen + 1u) * nloc) {
            __builtin_amdgcn_fence(__ATOMIC_RELEASE, "agent");
            asm volatile("s_waitcnt vmcnt(0)" ::: "memory");
            const unsigned og = xb_add(&bar[XB_TOP], 1u);
            const unsigned tg = og / nx;
            if (og + 1u == (tg + 1u) * nx) xb_add(&bar[XB_TOPGEN], 1u);
            else XB_SPIN(xb_ld(&bar[XB_TOPGEN]) == tg, bar);
            __builtin_amdgcn_fence(__ATOMIC_ACQUIRE, "agent");
            xb_add(&bar[XB_XGEN(b.x)], 1u);
            asm volatile("s_waitcnt vmcnt(0)" ::: "memory");
        } else {
            XB_SPIN(xb_ld(&bar[XB_XGEN(b.x)]) == gen, bar);
            __builtin_amdgcn_fence(__ATOMIC_ACQUIRE, "agent");
            asm volatile("s_waitcnt vmcnt(0)" ::: "memory");
        }
    }
    __syncthreads();
}

struct Args {
    const float *x; const int* pos; const float *w_in, *q_g, *w_uq, *kv_g, *w_ukv, *conv_w, *w_out, *ln1_g, *ln1_b, *w_gu, *ffn_cw, *w_down, *ln2_g, *ln2_b;
    float* out; unsigned char* ws; int ph_lo, ph_hi;
};

__device__ __forceinline__ float wave_sum(float v) {
#pragma unroll
    for (int o = 1; o < 64; o <<= 1) v += __shfl_xor(v, o);
    return v;
}
__device__ __forceinline__ void transpose_item(const float* W, const float* g, int K, int N, bf16* WT, int k0, int n0, int dst_row0, LAS float* scr, int lane) {
#pragma unroll 8
    for (int i = 0; i < 32; ++i) { const int kk = 2 * i + (lane >> 5); float v = W[(size_t)(k0 + kk) * N + n0 + (lane & 31)]; if (g) v *= g[k0 + kk]; scr[kk * 33 + (lane & 31)] = v; }
    asm volatile("s_waitcnt lgkmcnt(0)" ::: "memory");
    const int c = lane & 7;
#pragma unroll
    for (int j = 0; j < 4; ++j) { const int n = (lane >> 3) + 8 * j; const LAS float* s = scr + (8 * c) * 33 + n;
        u32x4 o; o.x = cvtpk(s[0 * 33], s[1 * 33]); o.y = cvtpk(s[2 * 33], s[3 * 33]); o.z = cvtpk(s[4 * 33], s[5 * 33]); o.w = cvtpk(s[6 * 33], s[7 * 33]);
        *(u32x4*)(WT + (size_t)(dst_row0 + n) * K + k0 + 8 * c) = o; }
    asm volatile("s_waitcnt lgkmcnt(0)" ::: "memory");
}
__device__ __forceinline__ int map_win(int n0) {
    if (n0 < 768) return n0;
    if (n0 == 768) return 768;
    if (n0 == 800) return 896;
    if (n0 < 1856) return 1024 + (n0 - 832);
    if (n0 < 2880) { const int t = n0 - 1856; return 2048 + 256 * (t >> 7) + (t & 127); }
    { const int t = n0 - 2880; return 2048 + 256 * (t >> 7) + 128 + (t & 127); }
}
__device__ __forceinline__ int map_wuq(int n0) {
    const int h = n0 / 192, d = n0 % 192;
    if (d < 128) return h * 128 + d;
    if (d == 128) return 1024 + (h >> 2) * 256 + (h & 3) * 32;
    return 1024 + (h >> 2) * 256 + 128 + (h & 3) * 32;
}
__device__ __forceinline__ int map_wgu(int n0) {
    if (n0 < FF) return 256 * (n0 >> 7) + (n0 & 127);
    const int t = n0 - FF; return 256 * (t >> 7) + 128 + (t & 127);
}
__device__ __forceinline__ void sincos_acc(float x, float& s, float& c) {
    const double xd = (double)x;
    const double k = __builtin_rint(xd * 0.63661977236758134308);
    double r = __builtin_fma(-k, 1.57079632679489655800, xd); r = __builtin_fma(-k, 6.12323399573676603587e-17, r);
    const int q = ((int)k) & 3;
    const float rf = (float)r, r2 = rf * rf;
    const float sp = rf * (1.0f + r2 * (-1.6666667e-1f + r2 * (8.3333333e-3f + r2 * (-1.9841270e-4f + r2 * 2.7557319e-6f))));
    const float cp = 1.0f + r2 * (-0.5f + r2 * (4.1666667e-2f + r2 * (-1.3888889e-3f + r2 * (2.4801587e-5f + r2 * -2.7557319e-7f))));
    s = (q == 0) ? sp : (q == 1) ? cp : (q == 2) ? -sp : -cp;
    c = (q == 0) ? cp : (q == 1) ? -sp : (q == 2) ? -cp : sp;
}

__global__ void __launch_bounds__(NTHREADS, 2) mega_fwd(Args a) {
    extern __shared__ __attribute__((aligned(16))) unsigned char lds[];
    cg::grid_group grid = cg::this_grid();
    const int tid = threadIdx.x, lane = tid & 63, wave = __builtin_amdgcn_readfirstlane(tid >> 6);
    const int G = gridDim.x, bx = blockIdx.x;
    const int gw = bx * NWAVES + wave, NGW = G * NWAVES;
    unsigned char* ws = a.ws;
    float* ssq_q = (float*)(ws + WS_SSQQ); float* ssq_kv = (float*)(ws + WS_SSQKV); float* cs = (float*)(ws + WS_CS);
    bf16* Wd_t = (bf16*)(ws + WS_WD); bf16* Win_t = (bf16*)(ws + WS_WIN); bf16* Wuq_t = (bf16*)(ws + WS_WUQ); bf16* Wukv_t = (bf16*)(ws + WS_WUKV);
    bf16* Wout_t = (bf16*)(ws + WS_WOUT); bf16* Wgu_t = (bf16*)(ws + WS_WGU);
    bf16* X1b = (bf16*)(ws + WS_X1B); bf16* Xb = (bf16*)(ws + WS_XB); bf16* CQ = (bf16*)(ws + WS_CQ); bf16* CKV = (bf16*)(ws + WS_CKV);
    bf16* GBb = (bf16*)(ws + WS_GB); bf16* Pb = (bf16*)(ws + WS_P); bf16* Qb = (bf16*)(ws + WS_Q); bf16* Kb = (bf16*)(ws + WS_K); bf16* Vb = (bf16*)(ws + WS_V);
    bf16* MIX = (bf16*)(ws + WS_MIX); bf16* GU = (bf16*)(ws + WS_GU); bf16* ACT = (bf16*)(ws + WS_ACT);
    const int lo = a.ph_lo, hi_ = a.ph_hi;
    volatile LAS unsigned* xst = (volatile LAS unsigned*)((LAS unsigned char*)lds + 131072 + 128);
    if (tid == 0) { xst[0] = 0u; xst[1] = 0u; }
    __syncthreads();
    XcdBarrier xbar = xcd_barrier_post((unsigned*)(ws + WS_BAR), xst);
    if (hi_ > 1000) grid.sync();
#define IN(k) (lo <= (k) && (k) < hi_)
#ifdef PROBE_PHASE
#define PT_LDS ((volatile LAS unsigned long long*)((LAS unsigned char*)lds + 131072 + 256))
#define SEAM(k) do { if (IN(k) && IN((k) + 1)) xcd_barrier(xbar); \
    if (bx == 0 && tid == 0) { if ((k) + 1 == PROBE_PHASE) PT_LDS[0] = __builtin_amdgcn_s_memrealtime(); if ((k) == PROBE_PHASE) PT_LDS[1] = __builtin_amdgcn_s_memrealtime(); } } while (0)
#else
#define SEAM(k) do { if (IN(k) && IN((k) + 1)) xcd_barrier(xbar); } while (0)
#endif
    Epi E; E.mode = 0; E.CQ = CQ; E.CKV = CKV; E.GB = GBb; E.P = Pb; E.Q = Qb; E.K = Kb; E.V = Vb; E.GU = GU; E.ssq_q = ssq_q; E.ssq_kv = ssq_kv; E.cs = cs; E.x = a.x; E.out = a.out;
    PG8_LAS unsigned char* ring = (PG8_LAS unsigned char*)lds;

    if (IN(0)) {
        LAS float* scr = (LAS float*)((LAS unsigned char*)lds + wave * 16384);
        constexpr int I0 = (DM / 64) * (NIN / 32), I1 = (QL / 64) * (1536 / 32), I2 = (KVL / 64) * (2048 / 32), I3 = (DM / 64) * (DM / 32), I4 = (DM / 64) * (NGU / 32), I5 = (FF / 64) * (DM / 32);
        constexpr int NIT = I0 + I1 + I2 + I3 + I4 + I5;
        for (int it = gw; it < NIT; it += NGW) {
            int r = it;
            if (r < I4) { const int nb = NGU / 32, kb = r / nb, n0 = (r % nb) * 32; transpose_item(a.w_gu, nullptr, DM, NGU, Wgu_t, kb * 64, n0, map_wgu(n0), scr, lane); continue; } r -= I4;
            if (r < I5) { const int nb = DM / 32, kb = r / nb, n0 = (r % nb) * 32; transpose_item(a.w_down, nullptr, FF, DM, Wd_t, kb * 64, n0, n0, scr, lane); continue; } r -= I5;
            if (r < I0) { const int nb = NIN / 32, kb = r / nb, n0 = (r % nb) * 32; transpose_item(a.w_in, nullptr, DM, NIN, Win_t, kb * 64, n0, map_win(n0), scr, lane); continue; } r -= I0;
            if (r < I3) { const int nb = DM / 32, kb = r / nb, n0 = (r % nb) * 32; transpose_item(a.w_out, nullptr, DM, DM, Wout_t, kb * 64, n0, n0, scr, lane); continue; } r -= I3;
            if (r < I1) { const int nb = 1536 / 32, kb = r / nb, n0 = (r % nb) * 32; transpose_item(a.w_uq, a.q_g, QL, 1536, Wuq_t, kb * 64, n0, map_wuq(n0), scr, lane); continue; } r -= I1;
            { const int nb = 2048 / 32, kb = r / nb, n0 = (r % nb) * 32; transpose_item(a.w_ukv, a.kv_g, KVL, 2048, Wukv_t, kb * 64, n0, n0, scr, lane); }
        }
        for (int rr = gw; rr < 192; rr += NGW) { const int row = rr < 96 ? 800 + rr : 928 + (rr - 96);
            u32x4* p = (u32x4*)(Win_t + (size_t)row * DM); const u32x4 z = {0u, 0u, 0u, 0u};
#pragma unroll
            for (int j = 0; j < 4; ++j) p[lane + 64 * j] = z; }
        for (int m = gw; m < M; m += NGW) { const f32x4* xr = (const f32x4*)(a.x + (size_t)m * DM); u32x4* o = (u32x4*)(Xb + (size_t)m * DM);
#pragma unroll
            for (int j = 0; j < 4; ++j) { const f32x4 v0 = xr[2 * (lane + 64 * j)], v1 = xr[2 * (lane + 64 * j) + 1]; o[lane + 64 * j] = pack8(v0, v1); } }
        for (int i = bx * NTHREADS + tid; i < M; i += G * NTHREADS) { ssq_q[i] = 0.f; ssq_kv[i] = 0.f; }
        if (bx == 0 && tid < 128) ((unsigned*)(ws + WS_AFLAG))[tid] = 0u;
        for (int i = bx * NTHREADS + tid; i < M * 32; i += G * NTHREADS) { const int row = i >> 5, f = i & 31;
            const float inv = (float)exp2(-(double)f * (13.287712379549449 / 32.0));
            const float ang = (float)a.pos[row] * inv; float s, c; sincos_acc(ang, s, c);
            cs[(size_t)row * 64 + f] = c; cs[(size_t)row * 64 + 32 + f] = s; }
    }
    SEAM(0);
    if (IN(1)) {
        pg8::Gemm g{Xb, Win_t, M, NINP, DM}; pg8::StaticOrder S; S.init(M, NINP, G, bx); E.mode = 1;
        pg8::gemm_phase<Epi, pg8::StaticOrder, true, true>(ring, g, S, E);
    }
    SEAM(1);
    if (IN(2)) {
        { pg8::Gemm g{CQ, Wuq_t, M, 1536, QL}; pg8::StaticOrder S; S.init(M, 1536, G, bx); E.mode = 2;
          pg8::gemm_phase<Epi, pg8::StaticOrder, true, true>(ring, g, S, E); }
        { pg8::Gemm g{CKV, Wukv_t, M, 2048, KVL}; pg8::StaticOrder S; S.init(M, 2048, G, bx); E.mode = 3;
          pg8::gemm_phase<Epi, pg8::StaticOrder, true, true>(ring, g, S, E); }
        { const int cc = tid & 127, rg = tid >> 7;
          float w0[8], w1[8], w2[8];
#pragma unroll
          for (int j = 0; j < 8; ++j) { w0[j] = a.conv_w[cc * 8 + j]; w1[j] = a.conv_w[CW + cc * 8 + j]; w2[j] = a.conv_w[2 * CW + cc * 8 + j]; }
          for (int it = bx; it < M / 32; it += G) {
              const int r0 = it * 32 + rg * 8;
              float pm2[8], pm1[8];
              if ((r0 & (SEQ - 1)) == 0) {
#pragma unroll
                  for (int j = 0; j < 8; ++j) { pm2[j] = 0.f; pm1[j] = 0.f; }
              } else { unpack8(*(const u32x4*)(Pb + (size_t)(r0 - 2) * CW + cc * 8), pm2); unpack8(*(const u32x4*)(Pb + (size_t)(r0 - 1) * CW + cc * 8), pm1); }
#pragma unroll
              for (int r = 0; r < 8; ++r) { float pc[8], gb[8], o[8];
                  unpack8(*(const u32x4*)(Pb + (size_t)(r0 + r) * CW + cc * 8), pc); unpack8(*(const u32x4*)(GBb + (size_t)(r0 + r) * CW + cc * 8), gb);
#pragma unroll
                  for (int j = 0; j < 8; ++j) { o[j] = gb[j] * (w2[j] * pc[j] + w1[j] * pm1[j] + w0[j] * pm2[j]); pm2[j] = pm1[j]; pm1[j] = pc[j]; }
                  u32x4 w = {cvtpk(o[0], o[1]), cvtpk(o[2], o[3]), cvtpk(o[4], o[5]), cvtpk(o[6], o[7])};
                  *(u32x4*)(MIX + (size_t)(r0 + r) * DM + CW + cc * 8) = w; }
          } }
    }
    SEAM(2);
    if (IN(3)) {
        float* PART = (float*)(ws + WS_PART); unsigned* AFLAG = (unsigned*)(ws + WS_AFLAG);
        constexpr int PSZ = 64 * 512 + 1024;
#pragma nounroll
        for (int uu = bx; uu < 256; uu += G) {
            const int xcd = uu & 7, idx = uu >> 3;
            const int bh = 2 * xcd + (idx >> 4), xq = (idx >> 1) & 7, role = idx & 1;
            const bf16* Qh = Qb + (size_t)bh * SEQ * DQK; const bf16* Kh = Kb + (size_t)bh * SEQ * DQK; const bf16* Vh = Vb + (size_t)bh * SEQ * DV;
            bf16* Oh = MIX + (size_t)(bh >> 3) * SEQ * DM + (bh & 7) * DV;
            const int hq = 15 - xq;
            float* pb = PART + (size_t)(bh * 8 + xq) * 2 * PSZ;
            att::BlockRef hb{Qh + (size_t)hq * 256 * DQK, Kh, Vh, Oh + (size_t)hq * 256 * DM, hq * 256, 0, 34, pb + role * PSZ, pb + (1 - role) * PSZ, AFLAG + bh * 8 + xq};
            att::Seam S;
            att::BlockRef cur = hb;
            if (role != 0) {
                hb.t0 = 34; hb.t1 = 4 * (hq + 1);
                cur = att::BlockRef{Qh + (size_t)xq * 256 * DQK, Kh, Vh, Oh + (size_t)xq * 256 * DM, xq * 256, 0, 4 * (xq + 1), nullptr, nullptr, nullptr};
            }
            att::attn_prime(cur, (char*)lds, S);
#pragma nounroll
            for (int i = 0; i <= role; ++i) { att::attn_block(cur, hb, (char*)lds, S); cur = hb; }
        }
    }
    SEAM(3);
    if (IN(4)) {
        pg8::Gemm g{MIX, Wout_t, M, DM, DM}; pg8::StaticOrder S; S.init(M, DM, G, bx); E.mode = 4;
        pg8::gemm_phase<Epi, pg8::StaticOrder, true, true>(ring, g, S, E);
    }
    SEAM(4);
    if (IN(5)) {
        for (int m = gw; m < M; m += NGW) {
            f32x4* xr = (f32x4*)(a.out + (size_t)m * DM) + lane; f32x4 v[8]; float s = 0.f;
#pragma unroll
            for (int j = 0; j < 8; ++j) { v[j] = xr[64 * j]; s += (v[j][0] + v[j][1]) + (v[j][2] + v[j][3]); }
            const float mean = wave_sum(s) * (1.f / DM); float s2 = 0.f;
#pragma unroll
            for (int j = 0; j < 8; ++j) { v[j] = v[j] - mean; s2 += (v[j][0] * v[j][0] + v[j][1] * v[j][1]) + (v[j][2] * v[j][2] + v[j][3] * v[j][3]); }
            const float rstd = 1.f / sqrtf(wave_sum(s2) * (1.f / DM) + LN_EPS);
            u32x2* ob = (u32x2*)(X1b + (size_t)m * DM) + lane;
#pragma unroll
            for (int j = 0; j < 8; ++j) { const f32x4 gg = ((const f32x4*)a.ln1_g)[lane + 64 * j], bb = ((const f32x4*)a.ln1_b)[lane + 64 * j];
                const f32x4 y = v[j] * rstd * gg + bb; xr[64 * j] = y; u32x2 w = {cvtpk(y[0], y[1]), cvtpk(y[2], y[3])}; ob[64 * j] = w; }
        }
    }
    SEAM(5);
    if (IN(6)) {
        pg8::Gemm g{X1b, Wgu_t, M, NGU, DM}; pg8::StaticOrder S; S.init(M, NGU, G, bx); E.mode = 5;
        pg8::gemm_phase<Epi, pg8::StaticOrder, true, true>(ring, g, S, E);
    }
    SEAM(6);
    if (IN(7)) {
        const int NCC = NGU / 16;
        const long total = (long)NCC * (M / 8);
        for (long uu = (long)bx * NTHREADS + tid; uu < total; uu += (long)G * NTHREADS) {
            const int cc = (int)(uu % NCC), rb = (int)(uu / NCC), r0 = rb * 8;
            const int j = cc >> 4, r8 = (cc & 15) * 8;
            const int cg_ = j * 128 + r8, cu_ = FF + cg_;
            const bf16* gp = GU + (size_t)j * 256 + r8; const bf16* up = gp + 128;
            float wg0[8], wg1[8], wg2[8], wu0[8], wu1[8], wu2[8];
#pragma unroll
            for (int q = 0; q < 8; ++q) { wg0[q] = a.ffn_cw[cg_ + q]; wg1[q] = a.ffn_cw[NGU + cg_ + q]; wg2[q] = a.ffn_cw[2 * NGU + cg_ + q];
                wu0[q] = a.ffn_cw[cu_ + q]; wu1[q] = a.ffn_cw[NGU + cu_ + q]; wu2[q] = a.ffn_cw[2 * NGU + cu_ + q]; }
            float g2[8], g1[8], u2[8], u1[8];
            if ((r0 & (SEQ - 1)) == 0) {
#pragma unroll
                for (int q = 0; q < 8; ++q) { g2[q] = 0.f; g1[q] = 0.f; u2[q] = 0.f; u1[q] = 0.f; }
            } else { unpack8(*(const u32x4*)(gp + (size_t)(r0 - 2) * NGU), g2); unpack8(*(const u32x4*)(gp + (size_t)(r0 - 1) * NGU), g1);
                     unpack8(*(const u32x4*)(up + (size_t)(r0 - 2) * NGU), u2); unpack8(*(const u32x4*)(up + (size_t)(r0 - 1) * NGU), u1); }
#pragma unroll
            for (int r = 0; r < 8; ++r) { float gc[8], uc[8], o[8];
                unpack8(*(const u32x4*)(gp + (size_t)(r0 + r) * NGU), gc); unpack8(*(const u32x4*)(up + (size_t)(r0 + r) * NGU), uc);
#pragma unroll
                for (int q = 0; q < 8; ++q) { const float gv = wg2[q] * gc[q] + wg1[q] * g1[q] + wg0[q] * g2[q], uv = wu2[q] * uc[q] + wu1[q] * u1[q] + wu0[q] * u2[q];
                    o[q] = gv / (1.f + __expf(-gv)) * uv; g2[q] = g1[q]; g1[q] = gc[q]; u2[q] = u1[q]; u1[q] = uc[q]; }
                u32x4 w = {cvtpk(o[0], o[1]), cvtpk(o[2], o[3]), cvtpk(o[4], o[5]), cvtpk(o[6], o[7])};
                *(u32x4*)(ACT + (size_t)(r0 + r) * FF + cg_) = w; }
        }
    }
    SEAM(7);
    if (IN(8)) {
        pg8::Gemm g{ACT, Wd_t, M, DM, FF}; pg8::StaticOrder S; S.init(M, DM, G, bx); E.mode = 6;
        pg8::gemm_phase<Epi, pg8::StaticOrder, true, true>(ring, g, S, E);
    }
    SEAM(8);
    if (IN(9)) {
        for (int m = gw; m < M; m += NGW) {
            f32x4* xr = (f32x4*)(a.out + (size_t)m * DM) + lane; f32x4 v[8]; float s = 0.f;
#pragma unroll
            for (int j = 0; j < 8; ++j) { v[j] = xr[64 * j]; s += (v[j][0] + v[j][1]) + (v[j][2] + v[j][3]); }
            const float mean = wave_sum(s) * (1.f / DM); float s2 = 0.f;
#pragma unroll
            for (int j = 0; j < 8; ++j) { v[j] = v[j] - mean; s2 += (v[j][0] * v[j][0] + v[j][1] * v[j][1]) + (v[j][2] * v[j][2] + v[j][3] * v[j][3]); }
            const float rstd = 1.f / sqrtf(wave_sum(s2) * (1.f / DM) + LN_EPS);
#pragma unroll
            for (int j = 0; j < 8; ++j) { const f32x4 gg = ((const f32x4*)a.ln2_g)[lane + 64 * j], bb = ((const f32x4*)a.ln2_b)[lane + 64 * j];
                xr[64 * j] = v[j] * rstd * gg + bb; }
        }
    }
#ifdef PROBE_PHASE
    if (bx == 0 && tid == 0) {
        const unsigned long long t1 = (PROBE_PHASE == 9) ? __builtin_amdgcn_s_memrealtime() : PT_LDS[1];
        const unsigned long long t0 = (PROBE_PHASE == 0) ? t1 : PT_LDS[0];
        const unsigned long long target = 10ull * (t1 - t0), ts = __builtin_amdgcn_s_memrealtime();
        while (__builtin_amdgcn_s_memrealtime() - ts < target) __builtin_amdgcn_s_sleep(8);
    }
#endif
#undef IN
#undef SEAM
}

#ifndef MK_PER_PHASE
#define MK_PER_PHASE 0
#endif
constexpr int NPHASE = 10;
extern "C" void kernel_launch(void* const* d_in, const int* in_sizes, int n_in, void* d_out, int out_size, void* d_ws, size_t ws_size, hipStream_t stream) {
    static int grid = 0;
    if (grid == 0) {
        if (n_in != 16 || in_sizes[0] != M * DM || out_size != M * DM || ws_size < WS_END) { fprintf(stderr, "kernel_launch: unexpected shapes (n_in %d, ws %zu)\n", n_in, ws_size); grid = -1; return; }
        int dev = 0, cus = 0, per_cu = 0;
        (void)hipGetDevice(&dev); (void)hipDeviceGetAttribute(&cus, hipDeviceAttributeMultiprocessorCount, dev);
        if (hipFuncSetAttribute((const void*)mega_fwd, hipFuncAttributeMaxDynamicSharedMemorySize, LDS_BYTES) != hipSuccess) { fprintf(stderr, "kernel_launch: hipFuncSetAttribute failed\n"); grid = -1; return; }
        if (hipOccupancyMaxActiveBlocksPerMultiprocessor(&per_cu, (const void*)mega_fwd, NTHREADS, LDS_BYTES) != hipSuccess || per_cu < 1) { fprintf(stderr, "kernel_launch: occupancy query says %d\n", per_cu); per_cu = 1; }
        (void)hipGetLastError();
        grid = cus > 0 ? cus : 256;
    }
    if (grid < 0) return;
    Args a{};
    a.x = (const float*)d_in[0]; a.pos = (const int*)d_in[1]; a.w_in = (const float*)d_in[2]; a.q_g = (const float*)d_in[3]; a.w_uq = (const float*)d_in[4];
    a.kv_g = (const float*)d_in[5]; a.w_ukv = (const float*)d_in[6]; a.conv_w = (const float*)d_in[7]; a.w_out = (const float*)d_in[8]; a.ln1_g = (const float*)d_in[9];
    a.ln1_b = (const float*)d_in[10]; a.w_gu = (const float*)d_in[11]; a.ffn_cw = (const float*)d_in[12]; a.w_down = (const float*)d_in[13]; a.ln2_g = (const float*)d_in[14]; a.ln2_b = (const float*)d_in[15];
    a.out = (float*)d_out; a.ws = (unsigned char*)d_ws;
#if MK_PER_PHASE
    for (int p = 0; p < NPHASE; ++p) { a.ph_lo = p; a.ph_hi = p + 1; hipLaunchKernelGGL(mega_fwd, dim3(grid), dim3(NTHREADS), LDS_BYTES, stream, a); }
#else
    (void)hipMemsetAsync((unsigned char*)d_ws + WS_BAR, 0, WS_BAR_BYTES, stream);
    a.ph_lo = 0; a.ph_hi = NPHASE;
    void* args[] = {&a};
    hipError_t e = hipLaunchCooperativeKernel((const void*)mega_fwd, dim3(grid), dim3(NTHREADS), args, LDS_BYTES, stream);
    if (e != hipSuccess) fprintf(stderr, "cooperative launch failed: %s (grid %d)\n", hipGetErrorString(e), grid);
#endif
}
```

```cpp
#include <hip/hip_runtime.h>
#include <hip/hip_cooperative_groups.h>
#include <cstdio>
#include <cstdint>
namespace cg = cooperative_groups;
namespace pg8 {
#define PG8_LAS __attribute__((address_space(3)))
typedef unsigned short bf16_t;
typedef short bf16x8 __attribute__((ext_vector_type(8)));
typedef float f32x4 __attribute__((ext_vector_type(4)));
typedef unsigned u32x4 __attribute__((ext_vector_type(4)));
constexpr int BM = 256, BK = 64, HALF = 128, HTB = HALF * BK * 2  , STAGE_BYTES = 8 * HTB, NXCD = 8, WGM = 8;

__host__ __device__ __forceinline__ int lds_byte(int r, int c) { const int st = (r >> 4) * 2 + (c >> 5), rr = r & 15, cc = c & 31, ob = rr * 64 + cc * 2; return st * 1024 + (ob ^ (((ob >> 9) & 1) << 5)); }
__host__ __device__ __forceinline__ void stage_rc(int b, int& R, int& C) { const int st = b / 1024, sb = b % 1024, swz = sb ^ (((sb >> 9) & 1) << 5); R = (st >> 1) * 16 + swz / 64; C = (st & 1) * 32 + (swz % 64) / 2; }
__host__ __device__ __forceinline__ int perm32(int rho) { const int n = rho >> 4, i = rho & 15; return 8 * (i >> 2) + 4 * n + (i & 3); }

struct Unit { int pm, pn; };
struct Gemm { const bf16_t* A; const bf16_t* Bt; int M, N, K; };

struct StaticOrder {
    int nM, nN, nwg, G, c;
    __host__ __device__ void init(int M, int N, int G_, int c_) { nM = M / BM; nN = N / BM; nwg = nM * nN; G = G_; c = c_; }
    __host__ __device__ bool next(int i, Unit& u) const {
        const long L = (long)i * G + c; if (L >= nwg) return false;
        int wgid = (int)L; { const int q = nwg / NXCD, r = nwg % NXCD, xcd = wgid % NXCD, off = wgid / NXCD; wgid = (xcd < r ? xcd * (q + 1) : r * (q + 1) + (xcd - r) * q) + off; }
        const int nig = WGM * nN, gid = wgid / nig, fm = gid * WGM, gsz = (nM - fm) < WGM ? (nM - fm) : WGM;
        u.pm = fm + ((wgid % nig) % gsz); u.pn = (wgid % nig) / gsz; return true;
    }
    __device__ __forceinline__ void a_ready(const Unit&) const {}
    __device__ __forceinline__ void done(const Unit&) const {}
};

__device__ __forceinline__ unsigned cvt_pk_bf16(float lo, float hi) { unsigned r; asm volatile("v_cvt_pk_bf16_f32 %0, %1, %2" : "=v"(r) : "v"(lo), "v"(hi)); return r; }
typedef float f32x2 __attribute__((ext_vector_type(2)));
template <class Epi, class Sched, bool ALIGN_EPI = false, bool SP2 = false>
__device__ __forceinline__ void gemm_phase(PG8_LAS unsigned char* lds, const Gemm g, const Sched& S, const Epi& E) {
    const int tid = threadIdx.x, wid = __builtin_amdgcn_readfirstlane(tid >> 6), lane = tid & 63, wr = wid >> 2, wc = wid & 3, fr = lane & 15, fq = lane >> 4;
    const int K = g.K, nt = K / BK;
    unsigned voffA[2], voffB[2];
#pragma unroll
    for (int i = 0; i < 2; ++i) { int R, C; stage_rc(tid * 16 + i * 8192, R, C); const int Rb = Epi::PERM ? ((R & ~31) + perm32(R & 31)) : R;
        voffA[i] = (unsigned)(R * K + C) * 2u; voffB[i] = (unsigned)(Rb * K + C) * 2u; }
    const size_t kstep = (size_t)(BK * 2);
    const size_t hstep = (size_t)HALF * K * 2;
    const size_t tstep = 2 * hstep;
    const unsigned ldsw = (unsigned)wid * 1024u;
    const int aoff = lds_byte(wr * 64 + fr, fq * 8), boff = lds_byte(wc * 32 + fr, fq * 8);
#define PG8_SA(b, h) (((b) * 2 + (h)) * HTB)
#define PG8_SB(b, h) ((4 + (b) * 2 + (h)) * HTB)
#define PG8_STAGE(bufoff, gbase, voff) do { _Pragma("unroll") for (int _i = 0; _i < 2; ++_i) \
        __builtin_amdgcn_global_load_lds((const unsigned*)((const char*)(gbase) + (voff)[_i]), (PG8_LAS unsigned*)(lds + (bufoff) + ldsw + _i * 8192), 16, 0, 0); } while (0)
#define PG8_LDA(dst, b, h) do { _Pragma("unroll") for (int m = 0; m < 4; ++m) _Pragma("unroll") for (int k = 0; k < 2; ++k) dst[m][k] = *(const PG8_LAS bf16x8*)(lds + PG8_SA(b, h) + aoff + m * 2048 + k * 1024); } while (0)
#define PG8_LDB(dst, b, h) do { _Pragma("unroll") for (int n = 0; n < 2; ++n) _Pragma("unroll") for (int k = 0; k < 2; ++k) dst[n][k] = *(const PG8_LAS bf16x8*)(lds + PG8_SB(b, h) + boff + n * 2048 + k * 1024); } while (0)
#define PG8_MMA(ai, bj, At, Bt) do { __builtin_amdgcn_s_setprio(1); _Pragma("unroll") for (int m = 0; m < 4; ++m) _Pragma("unroll") for (int n = 0; n < 2; ++n) _Pragma("unroll") for (int k = 0; k < 2; ++k) \
        acc[ai][bj][m][n] = __builtin_amdgcn_mfma_f32_16x16x32_bf16(Bt[n][k], At[m][k], acc[ai][bj][m][n], 0, 0, 0); __builtin_amdgcn_s_setprio(0); } while (0)
#define PG8_WAIT_V(n) asm volatile("s_waitcnt vmcnt(" #n ")" ::: "memory")
#define PG8_WAIT_L(n) asm volatile("s_waitcnt lgkmcnt(" #n ")" ::: "memory")
#define PG8_BAR __builtin_amdgcn_s_barrier()
#define PG8_SCHED __builtin_amdgcn_sched_barrier(0)
    Unit cur, nxt; int ui = 0;
    if (!S.next(0, cur)) return;
    f32x4 acc[2][2][4][2];
#pragma unroll
    for (int a = 0; a < 2; ++a)
#pragma unroll
        for (int b = 0; b < 2; ++b)
#pragma unroll
            for (int m = 0; m < 4; ++m)
#pragma unroll
                for (int n = 0; n < 2; ++n) acc[a][b][m][n] = (f32x4){0.f, 0.f, 0.f, 0.f};
    bf16x8 At[4][2], B0[2][2], B1[2][2];
    const char* cA = (const char*)g.A + (size_t)cur.pm * tstep; const char* cB = (const char*)g.Bt + (size_t)cur.pn * tstep;
    S.a_ready(cur);
    if constexpr (SP2) {
        PG8_STAGE(PG8_SB(0, 0), cB, voffB); PG8_STAGE(PG8_SB(0, 1), cB + hstep, voffB); PG8_STAGE(PG8_SA(0, 0), cA, voffA); PG8_STAGE(PG8_SA(0, 1), cA + hstep, voffA);
        if (wr == 1) PG8_BAR;
        PG8_WAIT_V(2); PG8_BAR;
        PG8_STAGE(PG8_SB(1, 0), cB + kstep, voffB); PG8_STAGE(PG8_SA(1, 0), cA + kstep, voffA); PG8_STAGE(PG8_SB(1, 1), cB + hstep + kstep, voffB);
        PG8_WAIT_V(6); PG8_BAR;
    } else {
        PG8_STAGE(PG8_SB(0, 0), cB, voffB); PG8_STAGE(PG8_SA(0, 0), cA, voffA); PG8_STAGE(PG8_SB(0, 1), cB + hstep, voffB); PG8_STAGE(PG8_SA(0, 1), cA + hstep, voffA);
        if (wr == 1) PG8_BAR;
        PG8_WAIT_V(4); PG8_BAR;
        PG8_STAGE(PG8_SB(1, 0), cB + kstep, voffB); PG8_STAGE(PG8_SA(1, 0), cA + kstep, voffA); PG8_STAGE(PG8_SB(1, 1), cB + hstep + kstep, voffB);
        PG8_WAIT_V(6); PG8_BAR;
    }
    for (;;) {
        const bool has_next = S.next(ui + 1, nxt);
        const char* nA = has_next ? (const char*)g.A + (size_t)nxt.pm * tstep : cA; const char* nB = has_next ? (const char*)g.Bt + (size_t)nxt.pn * tstep : cB;
        for (int t = 0; t < nt; t += 2) {
            const bool last = (t == nt - 2);
            const char* a1 = cA + (size_t)(t + 1) * kstep;
            const char* a2 = last ? nA : cA + (size_t)(t + 2) * kstep; const char* b2 = last ? nB : cB + (size_t)(t + 2) * kstep;
            const char* a3 = a2 + kstep; const char* b3 = b2 + kstep;
            if (last && has_next) S.a_ready(nxt);
            if constexpr (SP2) {
            PG8_LDB(B0, 0, 0); PG8_LDB(B1, 0, 1); PG8_SCHED; PG8_LDA(At, 0, 0); PG8_STAGE(PG8_SA(1, 1), a1 + hstep, voffA);
            PG8_WAIT_V(8); PG8_WAIT_L(0); PG8_BAR; PG8_MMA(0, 0, At, B0); PG8_MMA(0, 1, At, B1); PG8_BAR; PG8_SCHED;
            PG8_LDA(At, 0, 1); PG8_STAGE(PG8_SB(0, 0), b2, voffB); PG8_STAGE(PG8_SB(0, 1), b2 + hstep, voffB); PG8_STAGE(PG8_SA(0, 0), a2, voffA);
            PG8_WAIT_V(8); PG8_WAIT_L(0); PG8_BAR; PG8_MMA(1, 0, At, B0); PG8_MMA(1, 1, At, B1); PG8_BAR; PG8_SCHED;
            PG8_LDB(B0, 1, 0); PG8_LDB(B1, 1, 1); PG8_SCHED; PG8_LDA(At, 1, 0); PG8_STAGE(PG8_SA(0, 1), a2 + hstep, voffA);
            PG8_WAIT_V(8); PG8_WAIT_L(0); PG8_BAR; PG8_MMA(0, 0, At, B0); PG8_MMA(0, 1, At, B1); PG8_BAR; PG8_SCHED;
            PG8_LDA(At, 1, 1); PG8_STAGE(PG8_SB(1, 0), b3, voffB); PG8_STAGE(PG8_SB(1, 1), b3 + hstep, voffB); PG8_STAGE(PG8_SA(1, 0), a3, voffA);
            PG8_WAIT_V(8); PG8_WAIT_L(0); PG8_BAR; PG8_MMA(1, 0, At, B0); PG8_MMA(1, 1, At, B1); PG8_BAR; PG8_SCHED;
            } else {
            PG8_LDB(B0, 0, 0); PG8_SCHED; PG8_LDA(At, 0, 0); PG8_STAGE(PG8_SA(1, 1), a1 + hstep, voffA);
            PG8_WAIT_L(8); PG8_BAR; PG8_WAIT_L(0); PG8_MMA(0, 0, At, B0); PG8_BAR; PG8_SCHED;
            PG8_LDB(B1, 0, 1); PG8_STAGE(PG8_SB(0, 0), b2, voffB);
            PG8_BAR; PG8_WAIT_L(0); PG8_MMA(0, 1, At, B1); PG8_BAR;
            PG8_LDA(At, 0, 1); PG8_STAGE(PG8_SA(0, 0), a2, voffA);
            PG8_BAR; PG8_WAIT_L(0); PG8_MMA(1, 0, At, B0); PG8_BAR; PG8_SCHED;
            PG8_STAGE(PG8_SB(0, 1), b2 + hstep, voffB);
            PG8_WAIT_V(6); PG8_BAR; PG8_MMA(1, 1, At, B1); PG8_BAR;
            PG8_LDB(B0, 1, 0); PG8_SCHED; PG8_LDA(At, 1, 0); PG8_STAGE(PG8_SA(0, 1), a2 + hstep, voffA);
            PG8_WAIT_L(8); PG8_BAR; PG8_WAIT_L(0); PG8_MMA(0, 0, At, B0); PG8_BAR; PG8_SCHED;
            PG8_LDB(B1, 1, 1); PG8_STAGE(PG8_SB(1, 0), b3, voffB);
            PG8_BAR; PG8_WAIT_L(0); PG8_MMA(0, 1, At, B1); PG8_BAR;
            PG8_LDA(At, 1, 1); PG8_STAGE(PG8_SA(1, 0), a3, voffA);
            PG8_BAR; PG8_WAIT_L(0); PG8_MMA(1, 0, At, B0); PG8_BAR; PG8_SCHED;
            PG8_STAGE(PG8_SB(1, 1), b3 + hstep, voffB);
            PG8_WAIT_V(6); PG8_BAR; PG8_MMA(1, 1, At, B1); PG8_BAR;
            }
        }
        if constexpr (ALIGN_EPI) { if (wr == 0) PG8_BAR; }
        if constexpr (!Epi::AFTER_DRAIN) { E(acc, cur, wr, wc, fr, fq); S.done(cur); }
        if (!has_next) break;
#pragma unroll
        for (int a = 0; a < 2; ++a)
#pragma unroll
            for (int b = 0; b < 2; ++b)
#pragma unroll
                for (int m = 0; m < 4; ++m)
#pragma unroll
                    for (int n = 0; n < 2; ++n) acc[a][b][m][n] = (f32x4){0.f, 0.f, 0.f, 0.f};
        cur = nxt; cA = nA; cB = nB; ++ui;
        if constexpr (ALIGN_EPI) { if (wr == 1) PG8_BAR; }
    }
    PG8_WAIT_V(0);
    if constexpr (!ALIGN_EPI) { if (wr == 0) PG8_BAR; }
    PG8_BAR;
    if constexpr (Epi::AFTER_DRAIN) { E.fused(acc, cur, wr, wc, fr, fq, lds, wid, lane); S.done(cur); }
#undef PG8_SA
#undef PG8_SB
#undef PG8_STAGE
#undef PG8_LDA
#undef PG8_LDB
#undef PG8_MMA
#undef PG8_WAIT_V
#undef PG8_WAIT_L
#undef PG8_BAR
#undef PG8_SCHED
}
}
constexpr int SEQ = 4096, NBATCH = 2, M = NBATCH * SEQ, DM = 2048, NH = 8, DQK = 192, DV = 128;
constexpr int QL = 512, KVL = 256, CW = 1024, FF = 5632, NIN = 3904, NINP = 4096, NGU = 2 * FF;
constexpr float ALPHA = 1.189207115002721f;
constexpr float LN_EPS = 1e-5f, RMS_EPS = 1e-6f;

typedef unsigned short bf16;
typedef short bf16x8 __attribute__((ext_vector_type(8)));
typedef short s16x4 __attribute__((ext_vector_type(4)));
typedef float f32x4 __attribute__((ext_vector_type(4)));
typedef float f32x16 __attribute__((ext_vector_type(16)));
typedef unsigned u32x4 __attribute__((ext_vector_type(4)));
typedef unsigned u32x2 __attribute__((ext_vector_type(2)));
#define LAS __attribute__((address_space(3)))

constexpr size_t MiB = 1u << 20;
constexpr size_t WS_SSQQ = 0, WS_SSQKV = 64 * 1024;
constexpr size_t WS_CS = 1 * MiB;
constexpr size_t WS_WD = 3 * MiB, WS_WIN = 25 * MiB, WS_WUQ = 41 * MiB, WS_WUKV = 43 * MiB, WS_WOUT = 44 * MiB, WS_WGU = 52 * MiB;
constexpr size_t WS_X1B = 96 * MiB;
constexpr size_t WS_XB = 128 * MiB, WS_CQ = 160 * MiB, WS_CKV = 168 * MiB, WS_GB = 172 * MiB, WS_P = 188 * MiB;
constexpr size_t WS_Q = 204 * MiB, WS_K = 228 * MiB, WS_V = 252 * MiB, WS_MIX = 268 * MiB;
constexpr size_t WS_GU = 128 * MiB;
constexpr size_t WS_ACT = 25 * MiB;
constexpr size_t WS_PART = 304 * MiB;
constexpr size_t WS_BAR = 256 * 1024, WS_BAR_BYTES = 16 * 1024;
constexpr size_t WS_AFLAG = 128 * 1024;
constexpr size_t WS_END = 338 * MiB;

constexpr int NWAVES = 8, NTHREADS = 512;
constexpr int LDS_BYTES = 132096;

__device__ __forceinline__ unsigned cvtpk(float lo, float hi) { unsigned r; asm volatile("v_cvt_pk_bf16_f32 %0, %1, %2" : "=v"(r) : "v"(lo), "v"(hi)); return r; }
__device__ __forceinline__ u32x4 pack8(f32x4 a, f32x4 b) { u32x4 w = {cvtpk(a[0], a[1]), cvtpk(a[2], a[3]), cvtpk(b[0], b[1]), cvtpk(b[2], b[3])}; return w; }
__device__ __forceinline__ float bf2f(unsigned short h) { return __uint_as_float(((unsigned)h) << 16); }
__device__ __forceinline__ void unpack8(u32x4 w, float* f) {
#pragma unroll
    for (int i = 0; i < 4; ++i) { f[2 * i] = __uint_as_float(w[i] << 16); f[2 * i + 1] = __uint_as_float(w[i] & 0xffff0000u); }
}

struct Epi {
    static constexpr bool PERM = true, AFTER_DRAIN = false;
    int mode;
    bf16 *CQ, *CKV, *GB, *P, *Q, *K, *V, *GU;
    float *ssq_q, *ssq_kv; const float* cs; const float* x; float* out;
    __device__ __forceinline__ void operator()(const f32x4 (&acc)[2][2][4][2], const pg8::Unit& u, int wr, int wc, int fr, int fq) const {
        const int pn = u.pn, cb = wc * 32 + 8 * fq;
        const int rbase = u.pm * 256 + wr * 64 + fr;
        if (mode == 1) {
            if (pn < 3) {
#pragma unroll
                for (int ai = 0; ai < 2; ++ai)
#pragma unroll
                    for (int m = 0; m < 4; ++m) {
                        const int row = rbase + ai * 128 + m * 16;
                        bf16* dst = (pn < 2) ? (CQ + (size_t)row * QL + pn * 256) : (CKV + (size_t)row * KVL);
                        float ss = 0.f;
#pragma unroll
                        for (int bj = 0; bj < 2; ++bj) { const f32x4 v0 = acc[ai][bj][m][0], v1 = acc[ai][bj][m][1];
                            ss += (v0[0] * v0[0] + v0[1] * v0[1]) + (v0[2] * v0[2] + v0[3] * v0[3]) + (v1[0] * v1[0] + v1[1] * v1[1]) + (v1[2] * v1[2] + v1[3] * v1[3]);
                            *(u32x4*)(dst + bj * 128 + cb) = pack8(v0, v1); }
                        ss += __shfl_xor(ss, 16); ss += __shfl_xor(ss, 32);
                        if (fq == 0) atomicAdd(((pn < 2) ? ssq_q : ssq_kv) + row, ss);
                    }
            } else if (pn == 3) {
                if (wc == 0) {
#pragma unroll
                    for (int ai = 0; ai < 2; ++ai)
#pragma unroll
                        for (int m = 0; m < 4; ++m) {
                            const int row = rbase + ai * 128 + m * 16;
                            const float* c = cs + (size_t)row * 64 + 8 * fq;
                            const f32x4 c0 = *(const f32x4*)c, c1 = *(const f32x4*)(c + 4), s0 = *(const f32x4*)(c + 32), s1 = *(const f32x4*)(c + 36);
                            const f32x4 a0 = acc[ai][0][m][0], a1 = acc[ai][0][m][1], b0 = acc[ai][1][m][0], b1 = acc[ai][1][m][1];
                            const u32x4 o1 = pack8(a0 * c0 - b0 * s0, a1 * c1 - b1 * s1), o2 = pack8(a0 * s0 + b0 * c0, a1 * s1 + b1 * c1);
                            const int b = row >> 12, s_ = row & 4095;
#pragma unroll
                            for (int h = 0; h < NH; ++h) { bf16* kp = K + ((size_t)(b * NH + h) * SEQ + s_) * DQK + 128 + 8 * fq;
                                *(u32x4*)kp = o1; *(u32x4*)(kp + 32) = o2; }
                        }
                }
            } else if (pn < 8) {
#pragma unroll
                for (int ai = 0; ai < 2; ++ai)
#pragma unroll
                    for (int m = 0; m < 4; ++m) { const int row = rbase + ai * 128 + m * 16;
#pragma unroll
                        for (int bj = 0; bj < 2; ++bj) *(u32x4*)(GB + (size_t)row * CW + (pn - 4) * 256 + bj * 128 + cb) = pack8(acc[ai][bj][m][0], acc[ai][bj][m][1]); }
            } else {
#pragma unroll
                for (int ai = 0; ai < 2; ++ai)
#pragma unroll
                    for (int m = 0; m < 4; ++m) { const int row = rbase + ai * 128 + m * 16;
                        *(u32x4*)(P + (size_t)row * CW + (pn - 8) * 128 + cb) = pack8(acc[ai][0][m][0] * acc[ai][1][m][0], acc[ai][0][m][1] * acc[ai][1][m][1]); }
            }
        } else if (mode == 2) {
#pragma unroll
            for (int ai = 0; ai < 2; ++ai)
#pragma unroll
                for (int m = 0; m < 4; ++m) {
                    const int row = rbase + ai * 128 + m * 16; const int b = row >> 12, s_ = row & 4095;
                    const float rs = 1.0f / sqrtf(ssq_q[row] * (1.0f / QL) + RMS_EPS);
                    if (pn < 4) {
#pragma unroll
                        for (int bj = 0; bj < 2; ++bj) { const int head = 2 * pn + bj;
                            *(u32x4*)(Q + ((size_t)(b * NH + head) * SEQ + s_) * DQK + cb) = pack8(acc[ai][bj][m][0] * rs, acc[ai][bj][m][1] * rs); }
                    } else {
                        const int head = (pn - 4) * 4 + wc;
                        const float* c = cs + (size_t)row * 64 + 8 * fq;
                        const f32x4 c0 = *(const f32x4*)c, c1 = *(const f32x4*)(c + 4), s0 = *(const f32x4*)(c + 32), s1 = *(const f32x4*)(c + 36);
                        const f32x4 a0 = acc[ai][0][m][0] * rs, a1 = acc[ai][0][m][1] * rs, b0 = acc[ai][1][m][0] * rs, b1 = acc[ai][1][m][1] * rs;
                        bf16* qp = Q + ((size_t)(b * NH + head) * SEQ + s_) * DQK + 128 + 8 * fq;
                        *(u32x4*)qp = pack8(a0 * c0 - b0 * s0, a1 * c1 - b1 * s1); *(u32x4*)(qp + 32) = pack8(a0 * s0 + b0 * c0, a1 * s1 + b1 * c1);
                    }
                }
        } else if (mode == 3) {
#pragma unroll
            for (int ai = 0; ai < 2; ++ai)
#pragma unroll
                for (int m = 0; m < 4; ++m) {
                    const int row = rbase + ai * 128 + m * 16; const int b = row >> 12, s_ = row & 4095;
                    const float rs = 1.0f / sqrtf(ssq_kv[row] * (1.0f / KVL) + RMS_EPS);
                    const size_t tok = (size_t)(b * NH + pn) * SEQ + s_;
                    *(u32x4*)(K + tok * DQK + cb) = pack8(acc[ai][0][m][0] * rs, acc[ai][0][m][1] * rs);
                    *(u32x4*)(V + tok * DV + cb) = pack8(acc[ai][1][m][0] * rs, acc[ai][1][m][1] * rs);
                }
        } else if (mode == 4) {
#pragma unroll
            for (int ai = 0; ai < 2; ++ai)
#pragma unroll
                for (int m = 0; m < 4; ++m) { const int row = rbase + ai * 128 + m * 16;
#pragma unroll
                    for (int bj = 0; bj < 2; ++bj) { const size_t idx = (size_t)row * DM + pn * 256 + bj * 128 + cb;
                        const f32x4 x0 = *(const f32x4*)(x + idx), x1 = *(const f32x4*)(x + idx + 4);
                        *(f32x4*)(out + idx) = x0 * ALPHA + acc[ai][bj][m][0]; *(f32x4*)(out + idx + 4) = x1 * ALPHA + acc[ai][bj][m][1]; } }
        } else if (mode == 5) {
#pragma unroll
            for (int ai = 0; ai < 2; ++ai)
#pragma unroll
                for (int m = 0; m < 4; ++m) { const int row = rbase + ai * 128 + m * 16;
#pragma unroll
                    for (int bj = 0; bj < 2; ++bj) *(u32x4*)(GU + (size_t)row * NGU + pn * 256 + bj * 128 + cb) = pack8(acc[ai][bj][m][0], acc[ai][bj][m][1]); }
        } else {
#pragma unroll
            for (int ai = 0; ai < 2; ++ai)
#pragma unroll
                for (int m = 0; m < 4; ++m) { const int row = rbase + ai * 128 + m * 16;
#pragma unroll
                    for (int bj = 0; bj < 2; ++bj) { const size_t idx = (size_t)row * DM + pn * 256 + bj * 128 + cb;
                        const f32x4 x0 = *(const f32x4*)(out + idx), x1 = *(const f32x4*)(out + idx + 4);
                        *(f32x4*)(out + idx) = x0 * ALPHA + acc[ai][bj][m][0]; *(f32x4*)(out + idx + 4) = x1 * ALPHA + acc[ai][bj][m][1]; } }
        }
    }
};

namespace att {
constexpr int NW = 8, QBLK = 32, KVBLK = 64, QB = 256;
constexpr int SHM_V = KVBLK * DV * 2, SHM_K = KVBLK * DQK * 2;
constexpr int ATT_LDS = 3 * SHM_V + 3 * SHM_K + NW * 64 * 4;
constexpr float SCALE = 0.07216878364870322f;
constexpr float THR = 8.f;
#define KSWZ(row, colB) ((row) * 384 + ((colB) ^ (((row) & 7) << 4)))
#define SBAR() __builtin_amdgcn_sched_barrier(0)
__device__ __forceinline__ int v_st(int k, int c) { const int kk = (k & ~0xC) | ((k & 4) << 1) | ((k & 8) >> 1); return ((kk >> 3) * 4 + (c >> 5)) * 512 + ((kk & 7) * 32 + (c & 31)) * 2; }
__device__ __forceinline__ int v_rd_base(int lane) { return ((lane & 3) << 3) | (((lane >> 2) & 3) << 6) | (((lane >> 4) & 1) << 5) | (((lane >> 5) & 1) << 8); }
constexpr int v_rd_off(int d0, int ks, int half) { return d0 * 512 + ks * 4096 + half * 2048; }
__device__ __forceinline__ int crow(int r, int hi) { return (r & 3) + 8 * (r >> 2) + 4 * hi; }
__device__ __forceinline__ void mask_tile(f32x16& p0, f32x16& p1, int dq, unsigned W) {
    const float NEG = -__builtin_inff();
#pragma unroll
    for (int r = 0; r < 16; ++r) { const int c = (r & 3) + 8 * (r >> 2);
        if ((unsigned)(dq - c) >= W) p0[r] = NEG;
        if ((unsigned)(dq - c - 32) >= W) p1[r] = NEG; }
}
__device__ __forceinline__ void partialSM(f32x16& p0, f32x16& p1, float& m_reg, float& mn, float& alpha) {
    float pmax = p0[0];
#pragma unroll
    for (int r = 1; r < 16; ++r) pmax = fmaxf(pmax, p0[r]);
#pragma unroll
    for (int r = 0; r < 16; ++r) pmax = fmaxf(pmax, p1[r]);
    { auto rr = __builtin_amdgcn_permlane32_swap(__float_as_uint(pmax), __float_as_uint(pmax), false, false);
      pmax = fmaxf(__uint_as_float(rr[0]), __uint_as_float(rr[1])); }
    constexpr float C2 = 1.4426950408889634f * SCALE;
    if (__builtin_expect(__all((pmax - m_reg) * SCALE <= THR), 1)) { mn = m_reg; alpha = 1.f; }
    else { mn = fmaxf(m_reg, pmax); alpha = __builtin_amdgcn_exp2f((m_reg - mn) * C2); m_reg = mn; }
    const float mnL = -mn * C2;
#pragma unroll
    for (int r = 0; r < 16; ++r) p0[r] = fmaf(p0[r], C2, mnL);
#pragma unroll
    for (int r = 0; r < 16; ++r) p1[r] = fmaf(p1[r], C2, mnL);
#pragma unroll
    for (int r = 0; r < 16; ++r) p0[r] = __builtin_amdgcn_exp2f(p0[r]);
}
__device__ __forceinline__ void finishSM(f32x16& p0, f32x16& p1, float alpha, float& l_reg, bf16x8& pa0, bf16x8& pa1, bf16x8& pa2, bf16x8& pa3) {
#pragma unroll
    for (int r = 0; r < 16; ++r) p1[r] = __builtin_amdgcn_exp2f(p1[r]);
    float ps = 0;
#pragma unroll
    for (int r = 0; r < 16; ++r) ps += p0[r];
#pragma unroll
    for (int r = 0; r < 16; ++r) ps += p1[r];
    { auto rr = __builtin_amdgcn_permlane32_swap(__float_as_uint(ps), __float_as_uint(ps), false, false);
      ps = __uint_as_float(rr[0]) + __uint_as_float(rr[1]); }
    l_reg = l_reg * alpha + ps;
#define PK4(P_, B_, OUT) do { unsigned a0 = cvtpk(P_[B_+0], P_[B_+1]), a1 = cvtpk(P_[B_+2], P_[B_+3]);                          \
        unsigned b0 = cvtpk(P_[B_+4], P_[B_+5]), b1 = cvtpk(P_[B_+6], P_[B_+7]);                                             \
        auto r0 = __builtin_amdgcn_permlane32_swap(a0, b0, false, false); auto r1 = __builtin_amdgcn_permlane32_swap(a1, b1, false, false); \
        u32x4 w = {r0[0], r1[0], r0[1], r1[1]}; OUT = *reinterpret_cast<bf16x8*>(&w); } while (0)
    PK4(p0, 0, pa0); PK4(p0, 8, pa1); PK4(p1, 0, pa2); PK4(p1, 8, pa3);
#undef PK4
}
struct BlockRef { const bf16* Q; const bf16* K; const bf16* V; bf16* O; int P0; int t0, t1; float* part; const float* part_other; unsigned* flag; };
#define VMW() asm volatile("s_waitcnt vmcnt(0)" ::: "memory")
#define LD8(p) (*reinterpret_cast<const bf16x8*>(p))
__device__ __forceinline__ void mask_half(f32x16& p, int dq, unsigned W) {
    const float NEG = -__builtin_inff();
#pragma unroll
    for (int r = 0; r < 16; ++r) { const int c = (r & 3) + 8 * (r >> 2); if ((unsigned)(dq - c) >= W) p[r] = NEG; }
}
__device__ __forceinline__ void qk_half(f32x16& sc, const LAS unsigned char* kb, const int (&ko)[4], const bf16x8* qr) {
    sc = f32x16{};
#pragma unroll
    for (int d0 = 0; d0 < 12; ++d0) { const bf16x8 f = *(const LAS bf16x8*)(kb + ko[d0 & 3] + (d0 >> 2) * 128);
        sc = __builtin_amdgcn_mfma_f32_32x32x16_bf16(f, qr[d0], sc, 0, 0, 0); }
}
__device__ __forceinline__ void sm_half(f32x16& p, float& m_reg, float& l_reg, float& alpha, bf16x8& pa0, bf16x8& pa1) {
    float pmax = fmaxf(p[0], p[1]);
#pragma unroll
    for (int r = 2; r < 16; ++r) pmax = fmaxf(pmax, p[r]);
    { auto rr = __builtin_amdgcn_permlane32_swap(__float_as_uint(pmax), __float_as_uint(pmax), false, false);
      pmax = fmaxf(__uint_as_float(rr[0]), __uint_as_float(rr[1])); }
    constexpr float C2 = 1.4426950408889634f * SCALE;
    float mn;
    if (__builtin_expect(__all((pmax - m_reg) * SCALE <= THR), 1)) { mn = m_reg; alpha = 1.f; }
    else { mn = fmaxf(m_reg, pmax); alpha = __builtin_amdgcn_exp2f((m_reg - mn) * C2); m_reg = mn; }
    const float mnL = -mn * C2;
#pragma unroll
    for (int r = 0; r < 16; ++r) p[r] = __builtin_amdgcn_exp2f(fmaf(p[r], C2, mnL));
    float ps = (p[0] + p[1]) + (p[2] + p[3]);
#pragma unroll
    for (int r = 4; r < 16; r += 4) ps += (p[r] + p[r + 1]) + (p[r + 2] + p[r + 3]);
    { auto rr = __builtin_amdgcn_permlane32_swap(__float_as_uint(ps), __float_as_uint(ps), false, false);
      ps = __uint_as_float(rr[0]) + __uint_as_float(rr[1]); }
    l_reg = l_reg * alpha + ps;
#define PK4(P_, B_, OUT) do { unsigned a0 = cvtpk(P_[B_+0], P_[B_+1]), a1 = cvtpk(P_[B_+2], P_[B_+3]);                          \
        unsigned b0 = cvtpk(P_[B_+4], P_[B_+5]), b1 = cvtpk(P_[B_+6], P_[B_+7]);                                             \
        auto r0 = __builtin_amdgcn_permlane32_swap(a0, b0, false, false); auto r1 = __builtin_amdgcn_permlane32_swap(a1, b1, false, false); \
        u32x4 w = {r0[0], r1[0], r0[1], r1[1]}; OUT = *reinterpret_cast<bf16x8*>(&w); } while (0)
    PK4(p, 0, pa0); PK4(p, 8, pa1);
#undef PK4
}
template <int KS>
__device__ __forceinline__ void pv_half(f32x16* o, int vb, bf16x8 pa0, bf16x8 pa1) {
#define TRRD(dst, off) asm volatile("ds_read_b64_tr_b16 %0, %1 offset:%2" : "=&v"(dst) : "v"(vb), "i"(off) : "memory")
#define FR(l, h) (bf16x8){l[0], l[1], l[2], l[3], h[0], h[1], h[2], h[3]}
#define PV_PAIR(da, db) do { s16x4 la0, ha0, la1, ha1, lb0, hb0, lb1, hb1;  \
        TRRD(la0, v_rd_off(da, KS, 0)); TRRD(ha0, v_rd_off(da, KS, 1)); TRRD(lb0, v_rd_off(db, KS, 0)); TRRD(hb0, v_rd_off(db, KS, 1)); \
        TRRD(la1, v_rd_off(da, KS + 1, 0)); TRRD(ha1, v_rd_off(da, KS + 1, 1)); TRRD(lb1, v_rd_off(db, KS + 1, 0)); TRRD(hb1, v_rd_off(db, KS + 1, 1)); \
        asm volatile("s_waitcnt lgkmcnt(0)" ::: "memory"); SBAR();   \
        o[da] = __builtin_amdgcn_mfma_f32_32x32x16_bf16(pa0, FR(la0, ha0), o[da], 0, 0, 0);   \
        o[db] = __builtin_amdgcn_mfma_f32_32x32x16_bf16(pa0, FR(lb0, hb0), o[db], 0, 0, 0);   \
        o[da] = __builtin_amdgcn_mfma_f32_32x32x16_bf16(pa1, FR(la1, ha1), o[da], 0, 0, 0);   \
        o[db] = __builtin_amdgcn_mfma_f32_32x32x16_bf16(pa1, FR(lb1, hb1), o[db], 0, 0, 0); } while (0)
    PV_PAIR(0, 1); PV_PAIR(2, 3);
#undef PV_PAIR
#undef FR
#undef TRRD
}
__device__ __forceinline__ unsigned v_src(int q) {
    const int st = q >> 5, within = q & 31, kr = within >> 2, cch = within & 3, kk = (st >> 2) * 8 + kr;
    const int k = (kk & ~0xC) | ((kk & 4) << 1) | ((kk & 8) >> 1), c = (st & 3) * 32 + cch * 8;
    return (unsigned)(k * 256 + c * 2);
}
#define GLDS16(gp, ldsoff) __builtin_amdgcn_global_load_lds((const unsigned*)(gp), (LAS unsigned*)(lds3 + (ldsoff)), 16, 0, 0)
#define DMA_TILE(Kp, Vp, k0, bi) do { const char* kt_ = (const char*)((Kp) + (size_t)(k0) * DQK); const char* vt_ = (const char*)((Vp) + (size_t)(k0) * DV); \
        const int kbo_ = 3 * SHM_V + (bi) * SHM_K + wid * 1024, vbo_ = (bi) * SHM_V + wid * 1024; \
        GLDS16(kt_ + koff0, kbo_); GLDS16(kt_ + koff1, kbo_ + 8192); GLDS16(kt_ + koff2, kbo_ + 16384); \
        GLDS16(vt_ + voff0, vbo_); GLDS16(vt_ + voff1, vbo_ + 8192); } while (0)
__device__ __forceinline__ void attn_block(const BlockRef& cur, char* lds) {
    const int tid = threadIdx.x, wid = __builtin_amdgcn_readfirstlane(tid >> 6), lane = tid & 63, r32 = lane & 31, hi = lane >> 5;
    const unsigned W = 1u << 30;
    const int T0 = cur.t0, T1 = cur.t1;
    const int qlo = cur.P0 + wid * QBLK, qm = qlo + r32 - 4 * hi;
    LAS unsigned char* lds3 = (LAS unsigned char*)lds;
    const LAS unsigned char* K3 = lds3 + 3 * SHM_V;
    float* ws = (float*)(lds + 3 * SHM_V + 3 * SHM_K) + wid * 64; float* li_l = ws, * al_l = ws + 32;
    float m_reg = -1e30f, l_reg = 0; f32x16 o[4] = {};
    const int kp0 = wid * 64 + lane, kp1 = kp0 + 512, kp2 = kp0 + 1024;
    const unsigned koff0 = (kp0 / 24) * 384 + (((kp0 % 24) ^ ((kp0 / 24) & 7)) << 4), koff1 = (kp1 / 24) * 384 + (((kp1 % 24) ^ ((kp1 / 24) & 7)) << 4), koff2 = (kp2 / 24) * 384 + (((kp2 % 24) ^ ((kp2 / 24) & 7)) << 4);
    const unsigned voff0 = v_src(kp0), voff1 = v_src(kp0 + 512);
    const int vb0 = (int)(uintptr_t)lds + v_rd_base(lane);
    int ko[4];
#pragma unroll
    for (int dd = 0; dd < 4; ++dd) ko[dd] = KSWZ(r32, (dd * 16 + hi * 8) * 2);
    const bf16* Kh = cur.K; const bf16* Vh = cur.V;
#define RESC(a) do { if (__any((a) < 1.f)) { if (hi == 0) al_l[r32] = (a); asm volatile("s_waitcnt lgkmcnt(0)" ::: "memory");              \
                     for (int d_ = 0; d_ < 4; ++d_) for (int r = 0; r < 16; ++r) o[d_][r] *= al_l[crow(r, hi)]; } } while (0)
#define MASKH(P_, kb_) do { if ((kb_) + 31 > qlo) mask_half(P_, qm - (kb_), W); } while (0)
    __syncthreads();
    DMA_TILE(Kh, Vh, T0 * KVBLK, 0);
    if (T0 + 1 < T1) DMA_TILE(Kh, Vh, (T0 + 1) * KVBLK, 1);
    bf16x8 qr[12];
#pragma unroll
    for (int d0 = 0; d0 < 12; ++d0) qr[d0] = LD8(cur.Q + (size_t)(wid * QBLK + r32) * DQK + d0 * 16 + hi * 8);
    VMW();
    __syncthreads();
    f32x16 sA, sB; float al; bf16x8 pa0, pa1;
    qk_half(sA, K3, ko, qr);
    int i0 = 0, i1 = 1, i2 = 2;
    for (int t = T0; t < T1; ++t) {
        if (t > T0) { VMW(); __syncthreads(); }
        if (t + 2 < T1) DMA_TILE(Kh, Vh, (t + 2) * KVBLK, i2);
        SBAR();
        qk_half(sB, K3 + i0 * SHM_K + 32 * 384, ko, qr); SBAR();
        MASKH(sA, t * KVBLK); sm_half(sA, m_reg, l_reg, al, pa0, pa1); RESC(al); SBAR();
        pv_half<0>(o, vb0 + i0 * SHM_V, pa0, pa1); SBAR();
        if (t + 1 < T1) { qk_half(sA, K3 + i1 * SHM_K, ko, qr); } SBAR();
        MASKH(sB, t * KVBLK + 32); sm_half(sB, m_reg, l_reg, al, pa0, pa1); RESC(al); SBAR();
        pv_half<2>(o, vb0 + i0 * SHM_V, pa0, pa1); SBAR();
        { const int tmp = i0; i0 = i1; i1 = i2; i2 = tmp; }
    }
    bf16* Ow = cur.O + (size_t)(wid * QBLK) * DM;
    if (cur.part == nullptr) {
        if (hi == 0) li_l[r32] = l_reg; asm volatile("s_waitcnt lgkmcnt(0)" ::: "memory");
        float rli[16];
#pragma unroll
        for (int r = 0; r < 16; ++r) rli[r] = __builtin_amdgcn_rcpf(li_l[crow(r, hi)]);
#pragma unroll
        for (int r = 0; r < 16; ++r) { const int orow = crow(r, hi);
#pragma unroll
            for (int d0 = 0; d0 < 4; ++d0) { const float v = o[d0][r] * rli[r];
                const float vn = __shfl_xor(v, 1);
                if ((r32 & 1) == 0) *(unsigned*)(Ow + (size_t)orow * DM + d0 * 32 + r32) = cvtpk(v, vn); } }
    } else {
        float* mine = cur.part + tid;
#pragma unroll
        for (int d0 = 0; d0 < 4; ++d0)
#pragma unroll
            for (int r = 0; r < 16; ++r) __hip_atomic_store(mine + (d0 * 16 + r) * 512, o[d0][r], __ATOMIC_RELAXED, __HIP_MEMORY_SCOPE_AGENT);
        __hip_atomic_store(mine + 32768, m_reg, __ATOMIC_RELAXED, __HIP_MEMORY_SCOPE_AGENT);
        __hip_atomic_store(mine + 32768 + 512, l_reg, __ATOMIC_RELAXED, __HIP_MEMORY_SCOPE_AGENT);
        asm volatile("s_waitcnt vmcnt(0)" ::: "memory");
        __syncthreads();
        unsigned* fbox = (unsigned*)(lds + ATT_LDS);
        if (tid == 0) { *fbox = __hip_atomic_fetch_add(cur.flag, 1u, __ATOMIC_RELAXED, __HIP_MEMORY_SCOPE_AGENT); }
        __syncthreads();
        const unsigned old = *fbox;
        if (old == 1u) {
            const float* oth = cur.part_other + tid;
            constexpr float C2 = 1.4426950408889634f * SCALE;
            const float mo = __hip_atomic_load(oth + 32768, __ATOMIC_RELAXED, __HIP_MEMORY_SCOPE_AGENT), lo = __hip_atomic_load(oth + 32768 + 512, __ATOMIC_RELAXED, __HIP_MEMORY_SCOPE_AGENT);
            const float mm = fmaxf(m_reg, mo), fs = __builtin_amdgcn_exp2f((m_reg - mm) * C2), fo = __builtin_amdgcn_exp2f((mo - mm) * C2);
            const float il = 1.0f / (l_reg * fs + lo * fo);
            if (hi == 0) { li_l[r32] = fs * il; al_l[r32] = fo * il; }
            asm volatile("s_waitcnt lgkmcnt(0)" ::: "memory");
#pragma unroll
            for (int r = 0; r < 16; ++r) { const int orow = crow(r, hi); const float fa = li_l[orow], fb = al_l[orow];
#pragma unroll
                for (int d0 = 0; d0 < 4; ++d0) { const float v = o[d0][r] * fa + __hip_atomic_load(oth + (d0 * 16 + r) * 512, __ATOMIC_RELAXED, __HIP_MEMORY_SCOPE_AGENT) * fb;
                    const float vn = __shfl_xor(v, 1);
                    if ((r32 & 1) == 0) *(unsigned*)(Ow + (size_t)orow * DM + d0 * 32 + r32) = cvtpk(v, vn); }
                if ((r & 3) == 3) asm volatile("" ::: "memory"); }
        }
        __syncthreads();
    }
#undef RESC
#undef MASKH
}
#undef VMW
#undef GLDS16
#undef DMA_TILE
#undef LD8
}

#define XB_TMO      128
#define XB_XCNT(j)  (256  + 64 * (j))
#define XB_XSUB(j)  (1280 + 64 * (j))
#define XB_XGEN(j)  (2304 + 64 * (j))
#define XB_TOP      3328
#define XB_TOPGEN   3392
#define XCD_BAR_WORDS 3456
#define XB_SPIN_CAP (1u << 18)

__device__ __forceinline__ unsigned xb_ld(unsigned* p)              { return __hip_atomic_load(p, __ATOMIC_RELAXED, __HIP_MEMORY_SCOPE_AGENT); }
__device__ __forceinline__ unsigned xb_add(unsigned* p, unsigned v) { return __hip_atomic_fetch_add(p, v, __ATOMIC_RELAXED, __HIP_MEMORY_SCOPE_AGENT); }
__device__ __forceinline__ unsigned xb_xcc_id() { return (unsigned)__builtin_amdgcn_s_getreg((3 << 11) | 20) & 0xFu; }
#define XB_SPIN(cond, bar) do { unsigned _sp = 0; while (cond) { __builtin_amdgcn_s_sleep(1); \
    if ((++_sp & 255u) == 0u) { if (xb_ld(&(bar)[XB_TMO])) break; if (_sp > XB_SPIN_CAP) { atomicAdd(&(bar)[XB_TMO], 1u); break; } } } } while (0)

struct XcdBarrier {
    unsigned* bar; unsigned x;
    volatile LAS unsigned* st;
};

__device__ __forceinline__ XcdBarrier xcd_barrier_post(unsigned* bar, volatile LAS unsigned* st) {
    XcdBarrier b; b.bar = bar; b.x = xb_xcc_id(); b.st = st;
    if (threadIdx.x == 0) (void)xb_add(&bar[XB_XCNT(b.x)], 1u);
    return b;
}
__device__ __forceinline__ void xcd_barrier_complete(unsigned* bar, unsigned x, unsigned& nloc, unsigned& nx) {
    const unsigned G = gridDim.x * gridDim.y * gridDim.z;
    unsigned sum, cnt, mine, sp = 0u;
    for (;;) {
        sum = 0u; cnt = 0u; mine = 0u;
#pragma unroll
        for (unsigned j = 0; j < 16; ++j) { const unsigned c = xb_ld(&bar[XB_XCNT(j)]); sum += c; cnt += (c > 0u) ? 1u : 0u; mine = (j == x) ? c : mine; }
        if (sum == G) break;
        __builtin_amdgcn_s_sleep(1);
        if ((++sp & 255u) == 0u) { if (xb_ld(&bar[XB_TMO])) break; if (sp > XB_SPIN_CAP) { atomicAdd(&bar[XB_TMO], 1u); break; } }
    }
    nloc = mine > 0u ? mine : 1u; nx = cnt > 0u ? cnt : 1u;
}

__device__ __forceinline__ void xcd_barrier(const XcdBarrier& b) {
    asm volatile("s_waitcnt vmcnt(0)" ::: "memory");
    __syncthreads();
    if (threadIdx.x == 0) {
        unsigned* bar = b.bar;
        __builtin_amdgcn_s_waitcnt(0);
        unsigned nloc = b.st[0], nx = b.st[1];
        if (nloc == 0u) { xcd_barrier_complete(bar, b.x, nloc, nx); b.st[0] = nloc; b.st[1] = nx; }
        const unsigned old = xb_add(&bar[XB_XSUB(b.x)], 1u);
        const unsigned gen = old / nloc;
        if (old + 1u == (gen + 1u) * nloc) {
            __builtin_amdgcn_fence(__ATOMIC_RELEASE, "agent");
            asm volatile("s_waitcnt vmcnt(0)" ::: "memory");
            const unsigned og = xb_add(&bar[XB_TOP], 1u);
            const unsigned tg = og / nx;
            if (og + 1u == (tg + 1u) * nx) xb_add(&bar[XB_TOPGEN], 1u);
            else XB_SPIN(xb_ld(&bar[XB_TOPGEN]) == tg, bar);
            __builtin_amdgcn_fence(__ATOMIC_ACQUIRE, "agent");
            xb_add(&bar[XB_XGEN(b.x)], 1u);
            asm volatile("s_waitcnt vmcnt(0)" ::: "memory");
        } else {
            XB_SPIN(xb_ld(&bar[XB_XGEN(b.x)]) == gen, bar);
            __builtin_amdgcn_fence(__ATOMIC_ACQUIRE, "agent");
            asm volatile("s_waitcnt vmcnt(0)" ::: "memory");
        }
    }
    __syncthreads();
}

struct Args {
    const float *x; const int* pos; const float *w_in, *q_g, *w_uq, *kv_g, *w_ukv, *conv_w, *w_out, *ln1_g, *ln1_b, *w_gu, *ffn_cw, *w_down, *ln2_g, *ln2_b;
    float* out; unsigned char* ws; int ph_lo, ph_hi;
};

__device__ __forceinline__ float wave_sum(float v) {
#pragma unroll
    for (int o = 1; o < 64; o <<= 1) v += __shfl_xor(v, o);
    return v;
}
__device__ __forceinline__ void transpose_item(const float* W, const float* g, int K, int N, bf16* WT, int k0, int n0, int dst_row0, LAS float* scr, int lane) {
#pragma unroll 8
    for (int i = 0; i < 32; ++i) { const int kk = 2 * i + (lane >> 5); float v = W[(size_t)(k0 + kk) * N + n0 + (lane & 31)]; if (g) v *= g[k0 + kk]; scr[kk * 33 + (lane & 31)] = v; }
    asm volatile("s_waitcnt lgkmcnt(0)" ::: "memory");
    const int c = lane & 7;
#pragma unroll
    for (int j = 0; j < 4; ++j) { const int n = (lane >> 3) + 8 * j; const LAS float* s = scr + (8 * c) * 33 + n;
        u32x4 o; o.x = cvtpk(s[0 * 33], s[1 * 33]); o.y = cvtpk(s[2 * 33], s[3 * 33]); o.z = cvtpk(s[4 * 33], s[5 * 33]); o.w = cvtpk(s[6 * 33], s[7 * 33]);
        *(u32x4*)(WT + (size_t)(dst_row0 + n) * K + k0 + 8 * c) = o; }
    asm volatile("s_waitcnt lgkmcnt(0)" ::: "memory");
}
__device__ __forceinline__ int map_win(int n0) {
    if (n0 < 768) return n0;
    if (n0 == 768) return 768;
    if (n0 == 800) return 896;
    if (n0 < 1856) return 1024 + (n0 - 832);
    if (n0 < 2880) { const int t = n0 - 1856; return 2048 + 256 * (t >> 7) + (t & 127); }
    { const int t = n0 - 2880; return 2048 + 256 * (t >> 7) + 128 + (t & 127); }
}
__device__ __forceinline__ int map_wuq(int n0) {
    const int h = n0 / 192, d = n0 % 192;
    if (d < 128) return h * 128 + d;
    if (d == 128) return 1024 + (h >> 2) * 256 + (h & 3) * 32;
    return 1024 + (h >> 2) * 256 + 128 + (h & 3) * 32;
}
__device__ __forceinline__ int map_wgu(int n0) {
    if (n0 < FF) return 256 * (n0 >> 7) + (n0 & 127);
    const int t = n0 - FF; return 256 * (t >> 7) + 128 + (t & 127);
}
__device__ __forceinline__ void sincos_acc(float x, float& s, float& c) {
    const double xd = (double)x;
    const double k = __builtin_rint(xd * 0.63661977236758134308);
    double r = __builtin_fma(-k, 1.57079632679489655800, xd); r = __builtin_fma(-k, 6.12323399573676603587e-17, r);
    const int q = ((int)k) & 3;
    const float rf = (float)r, r2 = rf * rf;
    const float sp = rf * (1.0f + r2 * (-1.6666667e-1f + r2 * (8.3333333e-3f + r2 * (-1.9841270e-4f + r2 * 2.7557319e-6f))));
    const float cp = 1.0f + r2 * (-0.5f + r2 * (4.1666667e-2f + r2 * (-1.3888889e-3f + r2 * (2.4801587e-5f + r2 * -2.7557319e-7f))));
    s = (q == 0) ? sp : (q == 1) ? cp : (q == 2) ? -sp : -cp;
    c = (q == 0) ? cp : (q == 1) ? -sp : (q == 2) ? -cp : sp;
}

__global__ void __launch_bounds__(NTHREADS, 2) mega_fwd(Args a) {
    extern __shared__ __attribute__((aligned(16))) unsigned char lds[];
    cg::grid_group grid = cg::this_grid();
    const int tid = threadIdx.x, lane = tid & 63, wave = __builtin_amdgcn_readfirstlane(tid >> 6);
    const int G = gridDim.x, bx = blockIdx.x;
    const int gw = bx * NWAVES + wave, NGW = G * NWAVES;
    unsigned char* ws = a.ws;
    float* ssq_q = (float*)(ws + WS_SSQQ); float* ssq_kv = (float*)(ws + WS_SSQKV); float* cs = (float*)(ws + WS_CS);
    bf16* Wd_t = (bf16*)(ws + WS_WD); bf16* Win_t = (bf16*)(ws + WS_WIN); bf16* Wuq_t = (bf16*)(ws + WS_WUQ); bf16* Wukv_t = (bf16*)(ws + WS_WUKV);
    bf16* Wout_t = (bf16*)(ws + WS_WOUT); bf16* Wgu_t = (bf16*)(ws + WS_WGU);
    bf16* X1b = (bf16*)(ws + WS_X1B); bf16* Xb = (bf16*)(ws + WS_XB); bf16* CQ = (bf16*)(ws + WS_CQ); bf16* CKV = (bf16*)(ws + WS_CKV);
    bf16* GBb = (bf16*)(ws + WS_GB); bf16* Pb = (bf16*)(ws + WS_P); bf16* Qb = (bf16*)(ws + WS_Q); bf16* Kb = (bf16*)(ws + WS_K); bf16* Vb = (bf16*)(ws + WS_V);
    bf16* MIX = (bf16*)(ws + WS_MIX); bf16* GU = (bf16*)(ws + WS_GU); bf16* ACT = (bf16*)(ws + WS_ACT);
    const int lo = a.ph_lo, hi_ = a.ph_hi;
    volatile LAS unsigned* xst = (volatile LAS unsigned*)((LAS unsigned char*)lds + 131072 + 128);
    if (tid == 0) { xst[0] = 0u; xst[1] = 0u; }
    __syncthreads();
    XcdBarrier xbar = xcd_barrier_post((unsigned*)(ws + WS_BAR), xst);
    if (hi_ > 1000) grid.sync();
#define IN(k) (lo <= (k) && (k) < hi_)
#ifdef PROBE_PHASE
#define PT_LDS ((volatile LAS unsigned long long*)((LAS unsigned char*)lds + 131072 + 256))
#define SEAM(k) do { if (IN(k) && IN((k) + 1)) xcd_barrier(xbar); \
    if (bx == 0 && tid == 0) { if ((k) + 1 == PROBE_PHASE) PT_LDS[0] = __builtin_amdgcn_s_memrealtime(); if ((k) == PROBE_PHASE) PT_LDS[1] = __builtin_amdgcn_s_memrealtime(); } } while (0)
#else
#define SEAM(k) do { if (IN(k) && IN((k) + 1)) xcd_barrier(xbar); } while (0)
#endif
    Epi E; E.mode = 0; E.CQ = CQ; E.CKV = CKV; E.GB = GBb; E.P = Pb; E.Q = Qb; E.K = Kb; E.V = Vb; E.GU = GU; E.ssq_q = ssq_q; E.ssq_kv = ssq_kv; E.cs = cs; E.x = a.x; E.out = a.out;
    PG8_LAS unsigned char* ring = (PG8_LAS unsigned char*)lds;

    if (IN(0)) {
        LAS float* scr = (LAS float*)((LAS unsigned char*)lds + wave * 16384);
        constexpr int I0 = (DM / 64) * (NIN / 32), I1 = (QL / 64) * (1536 / 32), I2 = (KVL / 64) * (2048 / 32), I3 = (DM / 64) * (DM / 32), I4 = (DM / 64) * (NGU / 32), I5 = (FF / 64) * (DM / 32);
        constexpr int NIT = I0 + I1 + I2 + I3 + I4 + I5;
        for (int it = gw; it < NIT; it += NGW) {
            int r = it;
            if (r < I4) { const int nb = NGU / 32, kb = r / nb, n0 = (r % nb) * 32; transpose_item(a.w_gu, nullptr, DM, NGU, Wgu_t, kb * 64, n0, map_wgu(n0), scr, lane); continue; } r -= I4;
            if (r < I5) { const int nb = DM / 32, kb = r / nb, n0 = (r % nb) * 32; transpose_item(a.w_down, nullptr, FF, DM, Wd_t, kb * 64, n0, n0, scr, lane); continue; } r -= I5;
            if (r < I0) { const int nb = NIN / 32, kb = r / nb, n0 = (r % nb) * 32; transpose_item(a.w_in, nullptr, DM, NIN, Win_t, kb * 64, n0, map_win(n0), scr, lane); continue; } r -= I0;
            if (r < I3) { const int nb = DM / 32, kb = r / nb, n0 = (r % nb) * 32; transpose_item(a.w_out, nullptr, DM, DM, Wout_t, kb * 64, n0, n0, scr, lane); continue; } r -= I3;
            if (r < I1) { const int nb = 1536 / 32, kb = r / nb, n0 = (r % nb) * 32; transpose_item(a.w_uq, a.q_g, QL, 1536, Wuq_t, kb * 64, n0, map_wuq(n0), scr, lane); continue; } r -= I1;
            { const int nb = 2048 / 32, kb = r / nb, n0 = (r % nb) * 32; transpose_item(a.w_ukv, a.kv_g, KVL, 2048, Wukv_t, kb * 64, n0, n0, scr, lane); }
        }
        for (int rr = gw; rr < 192; rr += NGW) { const int row = rr < 96 ? 800 + rr : 928 + (rr - 96);
            u32x4* p = (u32x4*)(Win_t + (size_t)row * DM); const u32x4 z = {0u, 0u, 0u, 0u};
#pragma unroll
            for (int j = 0; j < 4; ++j) p[lane + 64 * j] = z; }
        for (int m = gw; m < M; m += NGW) { const f32x4* xr = (const f32x4*)(a.x + (size_t)m * DM); u32x4* o = (u32x4*)(Xb + (size_t)m * DM);
#pragma unroll
            for (int j = 0; j < 4; ++j) { const f32x4 v0 = xr[2 * (lane + 64 * j)], v1 = xr[2 * (lane + 64 * j) + 1]; o[lane + 64 * j] = pack8(v0, v1); } }
        for (int i = bx * NTHREADS + tid; i < M; i += G * NTHREADS) { ssq_q[i] = 0.f; ssq_kv[i] = 0.f; }
        if (bx == 0 && tid < 128) ((unsigned*)(ws + WS_AFLAG))[tid] = 0u;
        for (int i = bx * NTHREADS + tid; i < M * 32; i += G * NTHREADS) { const int row = i >> 5, f = i & 31;
            const float inv = (float)exp2(-(double)f * (13.287712379549449 / 32.0));
            const float ang = (float)a.pos[row] * inv; float s, c; sincos_acc(ang, s, c);
            cs[(size_t)row * 64 + f] = c; cs[(size_t)row * 64 + 32 + f] = s; }
    }
    SEAM(0);
    if (IN(1)) {
        pg8::Gemm g{Xb, Win_t, M, NINP, DM}; pg8::StaticOrder S; S.init(M, NINP, G, bx); E.mode = 1;
        pg8::gemm_phase<Epi, pg8::StaticOrder, true, true>(ring, g, S, E);
    }
    SEAM(1);
    if (IN(2)) {
        { pg8::Gemm g{CQ, Wuq_t, M, 1536, QL}; pg8::StaticOrder S; S.init(M, 1536, G, bx); E.mode = 2;
          pg8::gemm_phase<Epi, pg8::StaticOrder, true, true>(ring, g, S, E); }
        { pg8::Gemm g{CKV, Wukv_t, M, 2048, KVL}; pg8::StaticOrder S; S.init(M, 2048, G, bx); E.mode = 3;
          pg8::gemm_phase<Epi, pg8::StaticOrder, true, true>(ring, g, S, E); }
        { const int cc = tid & 127, rg = tid >> 7;
          float w0[8], w1[8], w2[8];
#pragma unroll
          for (int j = 0; j < 8; ++j) { w0[j] = a.conv_w[cc * 8 + j]; w1[j] = a.conv_w[CW + cc * 8 + j]; w2[j] = a.conv_w[2 * CW + cc * 8 + j]; }
          for (int it = bx; it < M / 32; it += G) {
              const int r0 = it * 32 + rg * 8;
              float pm2[8], pm1[8];
              if ((r0 & (SEQ - 1)) == 0) {
#pragma unroll
                  for (int j = 0; j < 8; ++j) { pm2[j] = 0.f; pm1[j] = 0.f; }
              } else { unpack8(*(const u32x4*)(Pb + (size_t)(r0 - 2) * CW + cc * 8), pm2); unpack8(*(const u32x4*)(Pb + (size_t)(r0 - 1) * CW + cc * 8), pm1); }
#pragma unroll
              for (int r = 0; r < 8; ++r) { float pc[8], gb[8], o[8];
                  unpack8(*(const u32x4*)(Pb + (size_t)(r0 + r) * CW + cc * 8), pc); unpack8(*(const u32x4*)(GBb + (size_t)(r0 + r) * CW + cc * 8), gb);
#pragma unroll
                  for (int j = 0; j < 8; ++j) { o[j] = gb[j] * (w2[j] * pc[j] + w1[j] * pm1[j] + w0[j] * pm2[j]); pm2[j] = pm1[j]; pm1[j] = pc[j]; }
                  u32x4 w = {cvtpk(o[0], o[1]), cvtpk(o[2], o[3]), cvtpk(o[4], o[5]), cvtpk(o[6], o[7])};
                  *(u32x4*)(MIX + (size_t)(r0 + r) * DM + CW + cc * 8) = w; }
          } }
    }
    SEAM(2);
    if (IN(3)) {
        float* PART = (float*)(ws + WS_PART); unsigned* AFLAG = (unsigned*)(ws + WS_AFLAG);
        constexpr int PSZ = 64 * 512 + 1024;
#pragma nounroll
        for (int uu = bx; uu < 256; uu += G) {
            const int xcd = uu & 7, idx = uu >> 3;
            const int bh = 2 * xcd + (idx >> 4), xq = (idx >> 1) & 7, role = idx & 1;
            const bf16* Qh = Qb + (size_t)bh * SEQ * DQK; const bf16* Kh = Kb + (size_t)bh * SEQ * DQK; const bf16* Vh = Vb + (size_t)bh * SEQ * DV;
            bf16* Oh = MIX + (size_t)(bh >> 3) * SEQ * DM + (bh & 7) * DV;
            const int hq = 15 - xq;
            float* pb = PART + (size_t)(bh * 8 + xq) * 2 * PSZ;
            att::BlockRef hb{Qh + (size_t)hq * 256 * DQK, Kh, Vh, Oh + (size_t)hq * 256 * DM, hq * 256, 0, 34, pb + role * PSZ, pb + (1 - role) * PSZ, AFLAG + bh * 8 + xq};
            att::BlockRef cur = hb;
            if (role != 0) {
                hb.t0 = 34; hb.t1 = 4 * (hq + 1);
                cur = att::BlockRef{Qh + (size_t)xq * 256 * DQK, Kh, Vh, Oh + (size_t)xq * 256 * DM, xq * 256, 0, 4 * (xq + 1), nullptr, nullptr, nullptr};
            }
#pragma nounroll
            for (int i = 0; i <= role; ++i) { att::attn_block(cur, (char*)lds); cur = hb; }
        }
    }
    SEAM(3);
    if (IN(4)) {
        pg8::Gemm g{MIX, Wout_t, M, DM, DM}; pg8::StaticOrder S; S.init(M, DM, G, bx); E.mode = 4;
        pg8::gemm_phase<Epi, pg8::StaticOrder, true, true>(ring, g, S, E);
    }
    SEAM(4);
    if (IN(5)) {
        for (int m = gw; m < M; m += NGW) {
            f32x4* xr = (f32x4*)(a.out + (size_t)m * DM) + lane; f32x4 v[8]; float s = 0.f;
#pragma unroll
            for (int j = 0; j < 8; ++j) { v[j] = xr[64 * j]; s += (v[j][0] + v[j][1]) + (v[j][2] + v[j][3]); }
            const float mean = wave_sum(s) * (1.f / DM); float s2 = 0.f;
#pragma unroll
            for (int j = 0; j < 8; ++j) { v[j] = v[j] - mean; s2 += (v[j][0] * v[j][0] + v[j][1] * v[j][1]) + (v[j][2] * v[j][2] + v[j][3] * v[j][3]); }
            const float rstd = 1.f / sqrtf(wave_sum(s2) * (1.f / DM) + LN_EPS);
            u32x2* ob = (u32x2*)(X1b + (size_t)m * DM) + lane;
#pragma unroll
            for (int j = 0; j < 8; ++j) { const f32x4 gg = ((const f32x4*)a.ln1_g)[lane + 64 * j], bb = ((const f32x4*)a.ln1_b)[lane + 64 * j];
                const f32x4 y = v[j] * rstd * gg + bb; xr[64 * j] = y; u32x2 w = {cvtpk(y[0], y[1]), cvtpk(y[2], y[3])}; ob[64 * j] = w; }
        }
    }
    SEAM(5);
    if (IN(6)) {
        pg8::Gemm g{X1b, Wgu_t, M, NGU, DM}; pg8::StaticOrder S; S.init(M, NGU, G, bx); E.mode = 5;
        pg8::gemm_phase<Epi, pg8::StaticOrder, true, true>(ring, g, S, E);
    }
    SEAM(6);
    if (IN(7)) {
        const int NCC = NGU / 16;
        const long total = (long)NCC * (M / 8);
        for (long uu = (long)bx * NTHREADS + tid; uu < total; uu += (long)G * NTHREADS) {
            const int cc = (int)(uu % NCC), rb = (int)(uu / NCC), r0 = rb * 8;
            const int j = cc >> 4, r8 = (cc & 15) * 8;
            const int cg_ = j * 128 + r8, cu_ = FF + cg_;
            const bf16* gp = GU + (size_t)j * 256 + r8; const bf16* up = gp + 128;
            float wg0[8], wg1[8], wg2[8], wu0[8], wu1[8], wu2[8];
#pragma unroll
            for (int q = 0; q < 8; ++q) { wg0[q] = a.ffn_cw[cg_ + q]; wg1[q] = a.ffn_cw[NGU + cg_ + q]; wg2[q] = a.ffn_cw[2 * NGU + cg_ + q];
                wu0[q] = a.ffn_cw[cu_ + q]; wu1[q] = a.ffn_cw[NGU + cu_ + q]; wu2[q] = a.ffn_cw[2 * NGU + cu_ + q]; }
            float g2[8], g1[8], u2[8], u1[8];
            if ((r0 & (SEQ - 1)) == 0) {
#pragma unroll
                for (int q = 0; q < 8; ++q) { g2[q] = 0.f; g1[q] = 0.f; u2[q] = 0.f; u1[q] = 0.f; }
            } else { unpack8(*(const u32x4*)(gp + (size_t)(r0 - 2) * NGU), g2); unpack8(*(const u32x4*)(gp + (size_t)(r0 - 1) * NGU), g1);
                     unpack8(*(const u32x4*)(up + (size_t)(r0 - 2) * NGU), u2); unpack8(*(const u32x4*)(up + (size_t)(r0 - 1) * NGU), u1); }
#pragma unroll
            for (int r = 0; r < 8; ++r) { float gc[8], uc[8], o[8];
                unpack8(*(const u32x4*)(gp + (size_t)(r0 + r) * NGU), gc); unpack8(*(const u32x4*)(up + (size_t)(r0 + r) * NGU), uc);
#pragma unroll
                for (int q = 0; q < 8; ++q) { const float gv = wg2[q] * gc[q] + wg1[q] * g1[q] + wg0[q] * g2[q], uv = wu2[q] * uc[q] + wu1[q] * u1[q] + wu0[q] * u2[q];
                    o[q] = gv / (1.f + __expf(-gv)) * uv; g2[q] = g1[q]; g1[q] = gc[q]; u2[q] = u1[q]; u1[q] = uc[q]; }
                u32x4 w = {cvtpk(o[0], o[1]), cvtpk(o[2], o[3]), cvtpk(o[4], o[5]), cvtpk(o[6], o[7])};
                *(u32x4*)(ACT + (size_t)(r0 + r) * FF + cg_) = w; }
        }
    }
    SEAM(7);
    if (IN(8)) {
        pg8::Gemm g{ACT, Wd_t, M, DM, FF}; pg8::StaticOrder S; S.init(M, DM, G, bx); E.mode = 6;
        pg8::gemm_phase<Epi, pg8::StaticOrder, true, true>(ring, g, S, E);
    }
    SEAM(8);
    if (IN(9)) {
        for (int m = gw; m < M; m += NGW) {
            f32x4* xr = (f32x4*)(a.out + (size_t)m * DM) + lane; f32x4 v[8]; float s = 0.f;
#pragma unroll
            for (int j = 0; j < 8; ++j) { v[j] = xr[64 * j]; s += (v[j][0] + v[j][1]) + (v[j][2] + v[j][3]); }
            const float mean = wave_sum(s) * (1.f / DM); float s2 = 0.f;
#pragma unroll
            for (int j = 0; j < 8; ++j) { v[j] = v[j] - mean; s2 += (v[j][0] * v[j][0] + v[j][1] * v[j][1]) + (v[j][2] * v[j][2] + v[j][3] * v[j][3]); }
            const float rstd = 1.f / sqrtf(wave_sum(s2) * (1.f / DM) + LN_EPS);
#pragma unroll
            for (int j = 0; j < 8; ++j) { const f32x4 gg = ((const f32x4*)a.ln2_g)[lane + 64 * j], bb = ((const f32x4*)a.ln2_b)[lane + 64 * j];
                xr[64 * j] = v[j] * rstd * gg + bb; }
        }
    }
#ifdef PROBE_PHASE
    if (bx == 0 && tid == 0) {
        const unsigned long long t1 = (PROBE_PHASE == 9) ? __builtin_amdgcn_s_memrealtime() : PT_LDS[1];
        const unsigned long long t0 = (PROBE_PHASE == 0) ? t1 : PT_LDS[0];
        const unsigned long long target = 10ull * (t1 - t0), ts = __builtin_amdgcn_s_memrealtime();
        while (__builtin_amdgcn_s_memrealtime() - ts < target) __builtin_amdgcn_s_sleep(8);
    }
#endif
#undef IN
#undef SEAM
}

#ifndef MK_PER_PHASE
#define MK_PER_PHASE 0
#endif
constexpr int NPHASE = 10;
extern "C" void kernel_launch(void* const* d_in, const int* in_sizes, int n_in, void* d_out, int out_size, void* d_ws, size_t ws_size, hipStream_t stream) {
    static int grid = 0;
    if (grid == 0) {
        if (n_in != 16 || in_sizes[0] != M * DM || out_size != M * DM || ws_size < WS_END) { fprintf(stderr, "kernel_launch: unexpected shapes (n_in %d, ws %zu)\n", n_in, ws_size); grid = -1; return; }
        int dev = 0, cus = 0, per_cu = 0;
        (void)hipGetDevice(&dev); (void)hipDeviceGetAttribute(&cus, hipDeviceAttributeMultiprocessorCount, dev);
        if (hipFuncSetAttribute((const void*)mega_fwd, hipFuncAttributeMaxDynamicSharedMemorySize, LDS_BYTES) != hipSuccess) { fprintf(stderr, "kernel_launch: hipFuncSetAttribute failed\n"); grid = -1; return; }
        if (hipOccupancyMaxActiveBlocksPerMultiprocessor(&per_cu, (const void*)mega_fwd, NTHREADS, LDS_BYTES) != hipSuccess || per_cu < 1) { fprintf(stderr, "kernel_launch: occupancy query says %d\n", per_cu); per_cu = 1; }
        (void)hipGetLastError();
        grid = cus > 0 ? cus : 256;
    }
    if (grid < 0) return;
    Args a{};
    a.x = (const float*)d_in[0]; a.pos = (const int*)d_in[1]; a.w_in = (const float*)d_in[2]; a.q_g = (const float*)d_in[3]; a.w_uq = (const float*)d_in[4];
    a.kv_g = (const float*)d_in[5]; a.w_ukv = (const float*)d_in[6]; a.conv_w = (const float*)d_in[7]; a.w_out = (const float*)d_in[8]; a.ln1_g = (const float*)d_in[9];
    a.ln1_b = (const float*)d_in[10]; a.w_gu = (const float*)d_in[11]; a.ffn_cw = (const float*)d_in[12]; a.w_down = (const float*)d_in[13]; a.ln2_g = (const float*)d_in[14]; a.ln2_b = (const float*)d_in[15];
    a.out = (float*)d_out; a.ws = (unsigned char*)d_ws;
#if MK_PER_PHASE
    for (int p = 0; p < NPHASE; ++p) { a.ph_lo = p; a.ph_hi = p + 1; hipLaunchKernelGGL(mega_fwd, dim3(grid), dim3(NTHREADS), LDS_BYTES, stream, a); }
#else
    (void)hipMemsetAsync((unsigned char*)d_ws + WS_BAR, 0, WS_BAR_BYTES, stream);
    a.ph_lo = 0; a.ph_hi = NPHASE;
    void* args[] = {&a};
    hipError_t e = hipLaunchCooperativeKernel((const void*)mega_fwd, dim3(grid), dim3(NTHREADS), args, LDS_BYTES, stream);
    if (e != hipSuccess) fprintf(stderr, "cooperative launch failed: %s (grid %d)\n", hipGetErrorString(e), grid);
#endif
}
```

```cpp
#include <hip/hip_runtime.h>
#include <hip/hip_cooperative_groups.h>
#include <cstdio>
#include <cstdint>
namespace cg = cooperative_groups;
namespace pg8 {
#define PG8_LAS __attribute__((address_space(3)))
typedef unsigned short bf16_t;
typedef short bf16x8 __attribute__((ext_vector_type(8)));
typedef float f32x4 __attribute__((ext_vector_type(4)));
typedef unsigned u32x4 __attribute__((ext_vector_type(4)));
constexpr int BM = 256, BK = 64, HALF = 128, HTB = HALF * BK * 2  , STAGE_BYTES = 8 * HTB, NXCD = 8, WGM = 8;

__host__ __device__ __forceinline__ int lds_byte(int r, int c) { const int st = (r >> 4) * 2 + (c >> 5), rr = r & 15, cc = c & 31, ob = rr * 64 + cc * 2; return st * 1024 + (ob ^ (((ob >> 9) & 1) << 5)); }
__host__ __device__ __forceinline__ void stage_rc(int b, int& R, int& C) { const int st = b / 1024, sb = b % 1024, swz = sb ^ (((sb >> 9) & 1) << 5); R = (st >> 1) * 16 + swz / 64; C = (st & 1) * 32 + (swz % 64) / 2; }
__host__ __device__ __forceinline__ int perm32(int rho) { const int n = rho >> 4, i = rho & 15; return 8 * (i >> 2) + 4 * n + (i & 3); }

struct Unit { int pm, pn; };
struct Gemm { const bf16_t* A; const bf16_t* Bt; int M, N, K; };

struct StaticOrder {
    int nM, nN, nwg, G, c;
    __host__ __device__ void init(int M, int N, int G_, int c_) { nM = M / BM; nN = N / BM; nwg = nM * nN; G = G_; c = c_; }
    __host__ __device__ bool next(int i, Unit& u) const {
        const long L = (long)i * G + c; if (L >= nwg) return false;
        int wgid = (int)L; { const int q = nwg / NXCD, r = nwg % NXCD, xcd = wgid % NXCD, off = wgid / NXCD; wgid = (xcd < r ? xcd * (q + 1) : r * (q + 1) + (xcd - r) * q) + off; }
        const int nig = WGM * nN, gid = wgid / nig, fm = gid * WGM, gsz = (nM - fm) < WGM ? (nM - fm) : WGM;
        u.pm = fm + ((wgid % nig) % gsz); u.pn = (wgid % nig) / gsz; return true;
    }
    __device__ __forceinline__ void a_ready(const Unit&) const {}
    __device__ __forceinline__ void done(const Unit&) const {}
};

__device__ __forceinline__ unsigned cvt_pk_bf16(float lo, float hi) { unsigned r; asm volatile("v_cvt_pk_bf16_f32 %0, %1, %2" : "=v"(r) : "v"(lo), "v"(hi)); return r; }
typedef float f32x2 __attribute__((ext_vector_type(2)));
template <class Epi, class Sched, bool ALIGN_EPI = false, bool SP2 = false>
__device__ __forceinline__ void gemm_phase(PG8_LAS unsigned char* lds, const Gemm g, const Sched& S, const Epi& E) {
    const int tid = threadIdx.x, wid = __builtin_amdgcn_readfirstlane(tid >> 6), lane = tid & 63, wr = wid >> 2, wc = wid & 3, fr = lane & 15, fq = lane >> 4;
    const int K = g.K, nt = K / BK;
    unsigned voffA[2], voffB[2];
#pragma unroll
    for (int i = 0; i < 2; ++i) { int R, C; stage_rc(tid * 16 + i * 8192, R, C); const int Rb = Epi::PERM ? ((R & ~31) + perm32(R & 31)) : R;
        voffA[i] = (unsigned)(R * K + C) * 2u; voffB[i] = (unsigned)(Rb * K + C) * 2u; }
    const size_t kstep = (size_t)(BK * 2);
    const size_t hstep = (size_t)HALF * K * 2;
    const size_t tstep = 2 * hstep;
    const unsigned ldsw = (unsigned)wid * 1024u;
    const int aoff = lds_byte(wr * 64 + fr, fq * 8), boff = lds_byte(wc * 32 + fr, fq * 8);
#define PG8_SA(b, h) (((b) * 2 + (h)) * HTB)
#define PG8_SB(b, h) ((4 + (b) * 2 + (h)) * HTB)
#define PG8_STAGE(bufoff, gbase, voff) do { _Pragma("unroll") for (int _i = 0; _i < 2; ++_i) \
        __builtin_amdgcn_global_load_lds((const unsigned*)((const char*)(gbase) + (voff)[_i]), (PG8_LAS unsigned*)(lds + (bufoff) + ldsw + _i * 8192), 16, 0, 0); } while (0)
#define PG8_LDA(dst, b, h) do { _Pragma("unroll") for (int m = 0; m < 4; ++m) _Pragma("unroll") for (int k = 0; k < 2; ++k) dst[m][k] = *(const PG8_LAS bf16x8*)(lds + PG8_SA(b, h) + aoff + m * 2048 + k * 1024); } while (0)
#define PG8_LDB(dst, b, h) do { _Pragma("unroll") for (int n = 0; n < 2; ++n) _Pragma("unroll") for (int k = 0; k < 2; ++k) dst[n][k] = *(const PG8_LAS bf16x8*)(lds + PG8_SB(b, h) + boff + n * 2048 + k * 1024); } while (0)
#define PG8_MMA(ai, bj, At, Bt) do { __builtin_amdgcn_s_setprio(1); _Pragma("unroll") for (int m = 0; m < 4; ++m) _Pragma("unroll") for (int n = 0; n < 2; ++n) _Pragma("unroll") for (int k = 0; k < 2; ++k) \
        acc[ai][bj][m][n] = __builtin_amdgcn_mfma_f32_16x16x32_bf16(Bt[n][k], At[m][k], acc[ai][bj][m][n], 0, 0, 0); __builtin_amdgcn_s_setprio(0); } while (0)
#define PG8_WAIT_V(n) asm volatile("s_waitcnt vmcnt(" #n ")" ::: "memory")
#define PG8_WAIT_L(n) asm volatile("s_waitcnt lgkmcnt(" #n ")" ::: "memory")
#define PG8_BAR __builtin_amdgcn_s_barrier()
#define PG8_SCHED __builtin_amdgcn_sched_barrier(0)
    Unit cur, nxt; int ui = 0;
    if (!S.next(0, cur)) return;
    f32x4 acc[2][2][4][2];
#pragma unroll
    for (int a = 0; a < 2; ++a)
#pragma unroll
        for (int b = 0; b < 2; ++b)
#pragma unroll
            for (int m = 0; m < 4; ++m)
#pragma unroll
                for (int n = 0; n < 2; ++n) acc[a][b][m][n] = (f32x4){0.f, 0.f, 0.f, 0.f};
    bf16x8 At[4][2], B0[2][2], B1[2][2];
    const char* cA = (const char*)g.A + (size_t)cur.pm * tstep; const char* cB = (const char*)g.Bt + (size_t)cur.pn * tstep;
    S.a_ready(cur);
    if constexpr (SP2) {
        PG8_STAGE(PG8_SB(0, 0), cB, voffB); PG8_STAGE(PG8_SB(0, 1), cB + hstep, voffB); PG8_STAGE(PG8_SA(0, 0), cA, voffA); PG8_STAGE(PG8_SA(0, 1), cA + hstep, voffA);
        if (wr == 1) PG8_BAR;
        PG8_WAIT_V(2); PG8_BAR;
        PG8_STAGE(PG8_SB(1, 0), cB + kstep, voffB); PG8_STAGE(PG8_SA(1, 0), cA + kstep, voffA); PG8_STAGE(PG8_SB(1, 1), cB + hstep + kstep, voffB);
        PG8_WAIT_V(6); PG8_BAR;
    } else {
        PG8_STAGE(PG8_SB(0, 0), cB, voffB); PG8_STAGE(PG8_SA(0, 0), cA, voffA); PG8_STAGE(PG8_SB(0, 1), cB + hstep, voffB); PG8_STAGE(PG8_SA(0, 1), cA + hstep, voffA);
        if (wr == 1) PG8_BAR;
        PG8_WAIT_V(4); PG8_BAR;
        PG8_STAGE(PG8_SB(1, 0), cB + kstep, voffB); PG8_STAGE(PG8_SA(1, 0), cA + kstep, voffA); PG8_STAGE(PG8_SB(1, 1), cB + hstep + kstep, voffB);
        PG8_WAIT_V(6); PG8_BAR;
    }
    for (;;) {
        const bool has_next = S.next(ui + 1, nxt);
        const char* nA = has_next ? (const char*)g.A + (size_t)nxt.pm * tstep : cA; const char* nB = has_next ? (const char*)g.Bt + (size_t)nxt.pn * tstep : cB;
        for (int t = 0; t < nt; t += 2) {
            const bool last = (t == nt - 2);
            const char* a1 = cA + (size_t)(t + 1) * kstep;
            const char* a2 = last ? nA : cA + (size_t)(t + 2) * kstep; const char* b2 = last ? nB : cB + (size_t)(t + 2) * kstep;
            const char* a3 = a2 + kstep; const char* b3 = b2 + kstep;
            if (last && has_next) S.a_ready(nxt);
            if constexpr (SP2) {
            PG8_LDB(B0, 0, 0); PG8_LDB(B1, 0, 1); PG8_SCHED; PG8_LDA(At, 0, 0); PG8_STAGE(PG8_SA(1, 1), a1 + hstep, voffA);
            PG8_WAIT_V(8); PG8_WAIT_L(0); PG8_BAR; PG8_MMA(0, 0, At, B0); PG8_MMA(0, 1, At, B1); PG8_BAR; PG8_SCHED;
            PG8_LDA(At, 0, 1); PG8_STAGE(PG8_SB(0, 0), b2, voffB); PG8_STAGE(PG8_SB(0, 1), b2 + hstep, voffB); PG8_STAGE(PG8_SA(0, 0), a2, voffA);
            PG8_WAIT_V(8); PG8_WAIT_L(0); PG8_BAR; PG8_MMA(1, 0, At, B0); PG8_MMA(1, 1, At, B1); PG8_BAR; PG8_SCHED;
            PG8_LDB(B0, 1, 0); PG8_LDB(B1, 1, 1); PG8_SCHED; PG8_LDA(At, 1, 0); PG8_STAGE(PG8_SA(0, 1), a2 + hstep, voffA);
            PG8_WAIT_V(8); PG8_WAIT_L(0); PG8_BAR; PG8_MMA(0, 0, At, B0); PG8_MMA(0, 1, At, B1); PG8_BAR; PG8_SCHED;
            PG8_LDA(At, 1, 1); PG8_STAGE(PG8_SB(1, 0), b3, voffB); PG8_STAGE(PG8_SB(1, 1), b3 + hstep, voffB); PG8_STAGE(PG8_SA(1, 0), a3, voffA);
            PG8_WAIT_V(8); PG8_WAIT_L(0); PG8_BAR; PG8_MMA(1, 0, At, B0); PG8_MMA(1, 1, At, B1); PG8_BAR; PG8_SCHED;
            } else {
            PG8_LDB(B0, 0, 0); PG8_SCHED; PG8_LDA(At, 0, 0); PG8_STAGE(PG8_SA(1, 1), a1 + hstep, voffA);
            PG8_WAIT_L(8); PG8_BAR; PG8_WAIT_L(0); PG8_MMA(0, 0, At, B0); PG8_BAR; PG8_SCHED;
            PG8_LDB(B1, 0, 1); PG8_STAGE(PG8_SB(0, 0), b2, voffB);
            PG8_BAR; PG8_WAIT_L(0); PG8_MMA(0, 1, At, B1); PG8_BAR;
            PG8_LDA(At, 0, 1); PG8_STAGE(PG8_SA(0, 0), a2, voffA);
            PG8_BAR; PG8_WAIT_L(0); PG8_MMA(1, 0, At, B0); PG8_BAR; PG8_SCHED;
            PG8_STAGE(PG8_SB(0, 1), b2 + hstep, voffB);
            PG8_WAIT_V(6); PG8_BAR; PG8_MMA(1, 1, At, B1); PG8_BAR;
            PG8_LDB(B0, 1, 0); PG8_SCHED; PG8_LDA(At, 1, 0); PG8_STAGE(PG8_SA(0, 1), a2 + hstep, voffA);
            PG8_WAIT_L(8); PG8_BAR; PG8_WAIT_L(0); PG8_MMA(0, 0, At, B0); PG8_BAR; PG8_SCHED;
            PG8_LDB(B1, 1, 1); PG8_STAGE(PG8_SB(1, 0), b3, voffB);
            PG8_BAR; PG8_WAIT_L(0); PG8_MMA(0, 1, At, B1); PG8_BAR;
            PG8_LDA(At, 1, 1); PG8_STAGE(PG8_SA(1, 0), a3, voffA);
            PG8_BAR; PG8_WAIT_L(0); PG8_MMA(1, 0, At, B0); PG8_BAR; PG8_SCHED;
            PG8_STAGE(PG8_SB(1, 1), b3 + hstep, voffB);
            PG8_WAIT_V(6); PG8_BAR; PG8_MMA(1, 1, At, B1); PG8_BAR;
            }
        }
        if constexpr (ALIGN_EPI) { if (wr == 0) PG8_BAR; }
        if constexpr (!Epi::AFTER_DRAIN) { E(acc, cur, wr, wc, fr, fq); S.done(cur); }
        if (!has_next) break;
#pragma unroll
        for (int a = 0; a < 2; ++a)
#pragma unroll
            for (int b = 0; b < 2; ++b)
#pragma unroll
                for (int m = 0; m < 4; ++m)
#pragma unroll
                    for (int n = 0; n < 2; ++n) acc[a][b][m][n] = (f32x4){0.f, 0.f, 0.f, 0.f};
        cur = nxt; cA = nA; cB = nB; ++ui;
        if constexpr (ALIGN_EPI) { if (wr == 1) PG8_BAR; }
    }
    PG8_WAIT_V(0);
    if constexpr (!ALIGN_EPI) { if (wr == 0) PG8_BAR; }
    PG8_BAR;
    if constexpr (Epi::AFTER_DRAIN) { E.fused(acc, cur, wr, wc, fr, fq, lds, wid, lane); S.done(cur); }
#undef PG8_SA
#undef PG8_SB
#undef PG8_STAGE
#undef PG8_LDA
#undef PG8_LDB
#undef PG8_MMA
#undef PG8_WAIT_V
#undef PG8_WAIT_L
#undef PG8_BAR
#undef PG8_SCHED
}
}
constexpr int SEQ = 4096, NBATCH = 2, M = NBATCH * SEQ, DM = 2048, NH = 8, DQK = 192, DV = 128;
constexpr int QL = 512, KVL = 256, CW = 1024, FF = 5632, NIN = 3904, NINP = 4096, NGU = 2 * FF;
constexpr float ALPHA = 1.189207115002721f;
constexpr float LN_EPS = 1e-5f, RMS_EPS = 1e-6f;

typedef unsigned short bf16;
typedef short bf16x8 __attribute__((ext_vector_type(8)));
typedef short s16x4 __attribute__((ext_vector_type(4)));
typedef float f32x4 __attribute__((ext_vector_type(4)));
typedef float f32x16 __attribute__((ext_vector_type(16)));
typedef unsigned u32x4 __attribute__((ext_vector_type(4)));
typedef unsigned u32x2 __attribute__((ext_vector_type(2)));
#define LAS __attribute__((address_space(3)))

constexpr size_t MiB = 1u << 20;
constexpr size_t WS_SSQQ = 0, WS_SSQKV = 64 * 1024;
constexpr size_t WS_CS = 1 * MiB;
constexpr size_t WS_WD = 3 * MiB, WS_WIN = 25 * MiB, WS_WUQ = 41 * MiB, WS_WUKV = 43 * MiB, WS_WOUT = 44 * MiB, WS_WGU = 52 * MiB;
constexpr size_t WS_X1B = 96 * MiB;
constexpr size_t WS_XB = 128 * MiB, WS_CQ = 160 * MiB, WS_CKV = 168 * MiB, WS_GB = 172 * MiB, WS_P = 188 * MiB;
constexpr size_t WS_Q = 204 * MiB, WS_K = 228 * MiB, WS_V = 252 * MiB, WS_MIX = 268 * MiB;
constexpr size_t WS_GU = 128 * MiB;
constexpr size_t WS_ACT = 25 * MiB;
constexpr size_t WS_PART = 304 * MiB;
constexpr size_t WS_BAR = 256 * 1024, WS_BAR_BYTES = 16 * 1024;
constexpr size_t WS_AFLAG = 128 * 1024;
constexpr size_t WS_END = 338 * MiB;

constexpr int NWAVES = 8, NTHREADS = 512;
constexpr int LDS_BYTES = 132096;

__device__ __forceinline__ unsigned cvtpk(float lo, float hi) { unsigned r; asm volatile("v_cvt_pk_bf16_f32 %0, %1, %2" : "=v"(r) : "v"(lo), "v"(hi)); return r; }
__device__ __forceinline__ u32x4 pack8(f32x4 a, f32x4 b) { u32x4 w = {cvtpk(a[0], a[1]), cvtpk(a[2], a[3]), cvtpk(b[0], b[1]), cvtpk(b[2], b[3])}; return w; }
__device__ __forceinline__ float bf2f(unsigned short h) { return __uint_as_float(((unsigned)h) << 16); }
__device__ __forceinline__ void unpack8(u32x4 w, float* f) {
#pragma unroll
    for (int i = 0; i < 4; ++i) { f[2 * i] = __uint_as_float(w[i] << 16); f[2 * i + 1] = __uint_as_float(w[i] & 0xffff0000u); }
}

struct Epi {
    static constexpr bool PERM = true, AFTER_DRAIN = false;
    int mode;
    bf16 *CQ, *CKV, *GB, *P, *Q, *K, *V, *GU;
    float *ssq_q, *ssq_kv; const float* cs; const float* x; float* out;
    __device__ __forceinline__ void operator()(const f32x4 (&acc)[2][2][4][2], const pg8::Unit& u, int wr, int wc, int fr, int fq) const {
        const int pn = u.pn, cb = wc * 32 + 8 * fq;
        const int rbase = u.pm * 256 + wr * 64 + fr;
        if (mode == 1) {
            if (pn < 3) {
#pragma unroll
                for (int ai = 0; ai < 2; ++ai)
#pragma unroll
                    for (int m = 0; m < 4; ++m) {
                        const int row = rbase + ai * 128 + m * 16;
                        bf16* dst = (pn < 2) ? (CQ + (size_t)row * QL + pn * 256) : (CKV + (size_t)row * KVL);
                        float ss = 0.f;
#pragma unroll
                        for (int bj = 0; bj < 2; ++bj) { const f32x4 v0 = acc[ai][bj][m][0], v1 = acc[ai][bj][m][1];
                            ss += (v0[0] * v0[0] + v0[1] * v0[1]) + (v0[2] * v0[2] + v0[3] * v0[3]) + (v1[0] * v1[0] + v1[1] * v1[1]) + (v1[2] * v1[2] + v1[3] * v1[3]);
                            *(u32x4*)(dst + bj * 128 + cb) = pack8(v0, v1); }
                        ss += __shfl_xor(ss, 16); ss += __shfl_xor(ss, 32);
                        if (fq == 0) atomicAdd(((pn < 2) ? ssq_q : ssq_kv) + row, ss);
                    }
            } else if (pn == 3) {
                if (wc == 0) {
#pragma unroll
                    for (int ai = 0; ai < 2; ++ai)
#pragma unroll
                        for (int m = 0; m < 4; ++m) {
                            const int row = rbase + ai * 128 + m * 16;
                            const float* c = cs + (size_t)row * 64 + 8 * fq;
                            const f32x4 c0 = *(const f32x4*)c, c1 = *(const f32x4*)(c + 4), s0 = *(const f32x4*)(c + 32), s1 = *(const f32x4*)(c + 36);
                            const f32x4 a0 = acc[ai][0][m][0], a1 = acc[ai][0][m][1], b0 = acc[ai][1][m][0], b1 = acc[ai][1][m][1];
                            const u32x4 o1 = pack8(a0 * c0 - b0 * s0, a1 * c1 - b1 * s1), o2 = pack8(a0 * s0 + b0 * c0, a1 * s1 + b1 * c1);
                            const int b = row >> 12, s_ = row & 4095;
#pragma unroll
                            for (int h = 0; h < NH; ++h) { bf16* kp = K + ((size_t)(b * NH + h) * SEQ + s_) * DQK + 128 + 8 * fq;
                                *(u32x4*)kp = o1; *(u32x4*)(kp + 32) = o2; }
                        }
                }
            } else if (pn < 8) {
#pragma unroll
                for (int ai = 0; ai < 2; ++ai)
#pragma unroll
                    for (int m = 0; m < 4; ++m) { const int row = rbase + ai * 128 + m * 16;
#pragma unroll
                        for (int bj = 0; bj < 2; ++bj) *(u32x4*)(GB + (size_t)row * CW + (pn - 4) * 256 + bj * 128 + cb) = pack8(acc[ai][bj][m][0], acc[ai][bj][m][1]); }
            } else {
#pragma unroll
                for (int ai = 0; ai < 2; ++ai)
#pragma unroll
                    for (int m = 0; m < 4; ++m) { const int row = rbase + ai * 128 + m * 16;
                        *(u32x4*)(P + (size_t)row * CW + (pn - 8) * 128 + cb) = pack8(acc[ai][0][m][0] * acc[ai][1][m][0], acc[ai][0][m][1] * acc[ai][1][m][1]); }
            }
        } else if (mode == 2) {
#pragma unroll
            for (int ai = 0; ai < 2; ++ai)
#pragma unroll
                for (int m = 0; m < 4; ++m) {
                    const int row = rbase + ai * 128 + m * 16; const int b = row >> 12, s_ = row & 4095;
                    const float rs = 1.0f / sqrtf(ssq_q[row] * (1.0f / QL) + RMS_EPS);
                    if (pn < 4) {
#pragma unroll
                        for (int bj = 0; bj < 2; ++bj) { const int head = 2 * pn + bj;
                            *(u32x4*)(Q + ((size_t)(b * NH + head) * SEQ + s_) * DQK + cb) = pack8(acc[ai][bj][m][0] * rs, acc[ai][bj][m][1] * rs); }
                    } else {
                        const int head = (pn - 4) * 4 + wc;
                        const float* c = cs + (size_t)row * 64 + 8 * fq;
                        const f32x4 c0 = *(const f32x4*)c, c1 = *(const f32x4*)(c + 4), s0 = *(const f32x4*)(c + 32), s1 = *(const f32x4*)(c + 36);
                        const f32x4 a0 = acc[ai][0][m][0] * rs, a1 = acc[ai][0][m][1] * rs, b0 = acc[ai][1][m][0] * rs, b1 = acc[ai][1][m][1] * rs;
                        bf16* qp = Q + ((size_t)(b * NH + head) * SEQ + s_) * DQK + 128 + 8 * fq;
                        *(u32x4*)qp = pack8(a0 * c0 - b0 * s0, a1 * c1 - b1 * s1); *(u32x4*)(qp + 32) = pack8(a0 * s0 + b0 * c0, a1 * s1 + b1 * c1);
                    }
                }
        } else if (mode == 3) {
#pragma unroll
            for (int ai = 0; ai < 2; ++ai)
#pragma unroll
                for (int m = 0; m < 4; ++m) {
                    const int row = rbase + ai * 128 + m * 16; const int b = row >> 12, s_ = row & 4095;
                    const float rs = 1.0f / sqrtf(ssq_kv[row] * (1.0f / KVL) + RMS_EPS);
                    const size_t tok = (size_t)(b * NH + pn) * SEQ + s_;
                    *(u32x4*)(K + tok * DQK + cb) = pack8(acc[ai][0][m][0] * rs, acc[ai][0][m][1] * rs);
                    *(u32x4*)(V + tok * DV + cb) = pack8(acc[ai][1][m][0] * rs, acc[ai][1][m][1] * rs);
                }
        } else if (mode == 4) {
#pragma unroll
            for (int ai = 0; ai < 2; ++ai)
#pragma unroll
                for (int m = 0; m < 4; ++m) { const int row = rbase + ai * 128 + m * 16;
#pragma unroll
                    for (int bj = 0; bj < 2; ++bj) { const size_t idx = (size_t)row * DM + pn * 256 + bj * 128 + cb;
                        const f32x4 x0 = *(const f32x4*)(x + idx), x1 = *(const f32x4*)(x + idx + 4);
                        *(f32x4*)(out + idx) = x0 * ALPHA + acc[ai][bj][m][0]; *(f32x4*)(out + idx + 4) = x1 * ALPHA + acc[ai][bj][m][1]; } }
        } else if (mode == 5) {
#pragma unroll
            for (int ai = 0; ai < 2; ++ai)
#pragma unroll
                for (int m = 0; m < 4; ++m) { const int row = rbase + ai * 128 + m * 16;
#pragma unroll
                    for (int bj = 0; bj < 2; ++bj) *(u32x4*)(GU + (size_t)row * NGU + pn * 256 + bj * 128 + cb) = pack8(acc[ai][bj][m][0], acc[ai][bj][m][1]); }
        } else {
#pragma unroll
            for (int ai = 0; ai < 2; ++ai)
#pragma unroll
                for (int m = 0; m < 4; ++m) { const int row = rbase + ai * 128 + m * 16;
#pragma unroll
                    for (int bj = 0; bj < 2; ++bj) { const size_t idx = (size_t)row * DM + pn * 256 + bj * 128 + cb;
                        const f32x4 x0 = *(const f32x4*)(out + idx), x1 = *(const f32x4*)(out + idx + 4);
                        *(f32x4*)(out + idx) = x0 * ALPHA + acc[ai][bj][m][0]; *(f32x4*)(out + idx + 4) = x1 * ALPHA + acc[ai][bj][m][1]; } }
        }
    }
};

namespace att {
constexpr int NW = 8, QBLK = 32, KVBLK = 64, QB = 256;
constexpr int SHM_V = KVBLK * DV * 2, SHM_K = KVBLK * DQK * 2;
constexpr int ATT_LDS = 3 * SHM_V + 3 * SHM_K + NW * 64 * 4;
constexpr float SCALE = 0.07216878364870322f;
constexpr float THR = 8.f;
#define KSWZ(row, colB) ((row) * 384 + ((colB) ^ (((row) & 7) << 4)))
#define SBAR() __builtin_amdgcn_sched_barrier(0)
__device__ __forceinline__ int v_st(int k, int c) { const int kk = (k & ~0xC) | ((k & 4) << 1) | ((k & 8) >> 1); return ((kk >> 3) * 4 + (c >> 5)) * 512 + ((kk & 7) * 32 + (c & 31)) * 2; }
__device__ __forceinline__ int v_rd_base(int lane) { return ((lane & 3) << 3) | (((lane >> 2) & 3) << 6) | (((lane >> 4) & 1) << 5) | (((lane >> 5) & 1) << 8); }
constexpr int v_rd_off(int d0, int ks, int half) { return d0 * 512 + ks * 4096 + half * 2048; }
__device__ __forceinline__ int crow(int r, int hi) { return (r & 3) + 8 * (r >> 2) + 4 * hi; }
__device__ __forceinline__ void mask_tile(f32x16& p0, f32x16& p1, int dq, unsigned W) {
    const float NEG = -__builtin_inff();
#pragma unroll
    for (int r = 0; r < 16; ++r) { const int c = (r & 3) + 8 * (r >> 2);
        if ((unsigned)(dq - c) >= W) p0[r] = NEG;
        if ((unsigned)(dq - c - 32) >= W) p1[r] = NEG; }
}
__device__ __forceinline__ void partialSM(f32x16& p0, f32x16& p1, float& m_reg, float& mn, float& alpha) {
    float pmax = p0[0];
#pragma unroll
    for (int r = 1; r < 16; ++r) pmax = fmaxf(pmax, p0[r]);
#pragma unroll
    for (int r = 0; r < 16; ++r) pmax = fmaxf(pmax, p1[r]);
    { auto rr = __builtin_amdgcn_permlane32_swap(__float_as_uint(pmax), __float_as_uint(pmax), false, false);
      pmax = fmaxf(__uint_as_float(rr[0]), __uint_as_float(rr[1])); }
    constexpr float C2 = 1.4426950408889634f * SCALE;
    if (__builtin_expect(__all((pmax - m_reg) * SCALE <= THR), 1)) { mn = m_reg; alpha = 1.f; }
    else { mn = fmaxf(m_reg, pmax); alpha = __builtin_amdgcn_exp2f((m_reg - mn) * C2); m_reg = mn; }
    const float mnL = -mn * C2;
#pragma unroll
    for (int r = 0; r < 16; ++r) p0[r] = fmaf(p0[r], C2, mnL);
#pragma unroll
    for (int r = 0; r < 16; ++r) p1[r] = fmaf(p1[r], C2, mnL);
#pragma unroll
    for (int r = 0; r < 16; ++r) p0[r] = __builtin_amdgcn_exp2f(p0[r]);
}
__device__ __forceinline__ void finishSM(f32x16& p0, f32x16& p1, float alpha, float& l_reg, bf16x8& pa0, bf16x8& pa1, bf16x8& pa2, bf16x8& pa3) {
#pragma unroll
    for (int r = 0; r < 16; ++r) p1[r] = __builtin_amdgcn_exp2f(p1[r]);
    float ps = 0;
#pragma unroll
    for (int r = 0; r < 16; ++r) ps += p0[r];
#pragma unroll
    for (int r = 0; r < 16; ++r) ps += p1[r];
    { auto rr = __builtin_amdgcn_permlane32_swap(__float_as_uint(ps), __float_as_uint(ps), false, false);
      ps = __uint_as_float(rr[0]) + __uint_as_float(rr[1]); }
    l_reg = l_reg * alpha + ps;
#define PK4(P_, B_, OUT) do { unsigned a0 = cvtpk(P_[B_+0], P_[B_+1]), a1 = cvtpk(P_[B_+2], P_[B_+3]);                          \
        unsigned b0 = cvtpk(P_[B_+4], P_[B_+5]), b1 = cvtpk(P_[B_+6], P_[B_+7]);                                             \
        auto r0 = __builtin_amdgcn_permlane32_swap(a0, b0, false, false); auto r1 = __builtin_amdgcn_permlane32_swap(a1, b1, false, false); \
        u32x4 w = {r0[0], r1[0], r0[1], r1[1]}; OUT = *reinterpret_cast<bf16x8*>(&w); } while (0)
    PK4(p0, 0, pa0); PK4(p0, 8, pa1); PK4(p1, 0, pa2); PK4(p1, 8, pa3);
#undef PK4
}
struct BlockRef { const bf16* Q; const bf16* K; const bf16* V; bf16* O; int P0; int t0, t1; float* part; const float* part_other; unsigned* flag; };
#define VMW() asm volatile("s_waitcnt vmcnt(0)" ::: "memory")
#define LD8(p) (*reinterpret_cast<const bf16x8*>(p))
__device__ __forceinline__ void mask_half(f32x16& p, int dq, unsigned W) {
    const float NEG = -__builtin_inff();
#pragma unroll
    for (int r = 0; r < 16; ++r) { const int c = (r & 3) + 8 * (r >> 2); if ((unsigned)(dq - c) >= W) p[r] = NEG; }
}
__device__ __forceinline__ void qk_half(f32x16& sc, int kb  , const int (&ko)[4], const bf16x8* qr) {
#define KRD(dst, base, off) asm volatile("ds_read_b128 %0, %1 offset:%2" : "=&v"(dst) : "v"(base), "i"(off) : "memory")
    const int a0 = kb + ko[0], a1 = kb + ko[1], a2 = kb + ko[2], a3 = kb + ko[3];
    bf16x8 fa0, fa1, fa2, fa3, fb0, fb1, fb2, fb3;
    KRD(fa0, a0, 0); KRD(fa1, a1, 0); KRD(fa2, a2, 0); KRD(fa3, a3, 0);
    KRD(fb0, a0, 128); KRD(fb1, a1, 128); KRD(fb2, a2, 128); KRD(fb3, a3, 128);
    sc = f32x16{};
    asm volatile("s_waitcnt lgkmcnt(4)" ::: "memory"); SBAR();
    sc = __builtin_amdgcn_mfma_f32_32x32x16_bf16(fa0, qr[0], sc, 0, 0, 0); sc = __builtin_amdgcn_mfma_f32_32x32x16_bf16(fa1, qr[1], sc, 0, 0, 0);
    sc = __builtin_amdgcn_mfma_f32_32x32x16_bf16(fa2, qr[2], sc, 0, 0, 0); sc = __builtin_amdgcn_mfma_f32_32x32x16_bf16(fa3, qr[3], sc, 0, 0, 0);
    SBAR();
    KRD(fa0, a0, 256); KRD(fa1, a1, 256); KRD(fa2, a2, 256); KRD(fa3, a3, 256);
    asm volatile("s_waitcnt lgkmcnt(4)" ::: "memory"); SBAR();
    sc = __builtin_amdgcn_mfma_f32_32x32x16_bf16(fb0, qr[4], sc, 0, 0, 0); sc = __builtin_amdgcn_mfma_f32_32x32x16_bf16(fb1, qr[5], sc, 0, 0, 0);
    sc = __builtin_amdgcn_mfma_f32_32x32x16_bf16(fb2, qr[6], sc, 0, 0, 0); sc = __builtin_amdgcn_mfma_f32_32x32x16_bf16(fb3, qr[7], sc, 0, 0, 0);
    asm volatile("s_waitcnt lgkmcnt(0)" ::: "memory"); SBAR();
    sc = __builtin_amdgcn_mfma_f32_32x32x16_bf16(fa0, qr[8], sc, 0, 0, 0); sc = __builtin_amdgcn_mfma_f32_32x32x16_bf16(fa1, qr[9], sc, 0, 0, 0);
    sc = __builtin_amdgcn_mfma_f32_32x32x16_bf16(fa2, qr[10], sc, 0, 0, 0); sc = __builtin_amdgcn_mfma_f32_32x32x16_bf16(fa3, qr[11], sc, 0, 0, 0);
#undef KRD
}
__device__ __forceinline__ void sm_half(f32x16& p, float& m_reg, float& l_reg, float& alpha, bf16x8& pa0, bf16x8& pa1) {
    float pmax = fmaxf(p[0], p[1]);
#pragma unroll
    for (int r = 2; r < 16; ++r) pmax = fmaxf(pmax, p[r]);
    { auto rr = __builtin_amdgcn_permlane32_swap(__float_as_uint(pmax), __float_as_uint(pmax), false, false);
      pmax = fmaxf(__uint_as_float(rr[0]), __uint_as_float(rr[1])); }
    constexpr float C2 = 1.4426950408889634f * SCALE;
    float mn;
    if (__builtin_expect(__all((pmax - m_reg) * SCALE <= THR), 1)) { mn = m_reg; alpha = 1.f; }
    else { mn = fmaxf(m_reg, pmax); alpha = __builtin_amdgcn_exp2f((m_reg - mn) * C2); m_reg = mn; }
    const float mnL = -mn * C2;
#pragma unroll
    for (int r = 0; r < 16; ++r) p[r] = __builtin_amdgcn_exp2f(fmaf(p[r], C2, mnL));
    float ps = (p[0] + p[1]) + (p[2] + p[3]);
#pragma unroll
    for (int r = 4; r < 16; r += 4) ps += (p[r] + p[r + 1]) + (p[r + 2] + p[r + 3]);
    { auto rr = __builtin_amdgcn_permlane32_swap(__float_as_uint(ps), __float_as_uint(ps), false, false);
      ps = __uint_as_float(rr[0]) + __uint_as_float(rr[1]); }
    l_reg = l_reg * alpha + ps;
#define PK4(P_, B_, OUT) do { unsigned a0 = cvtpk(P_[B_+0], P_[B_+1]), a1 = cvtpk(P_[B_+2], P_[B_+3]);                          \
        unsigned b0 = cvtpk(P_[B_+4], P_[B_+5]), b1 = cvtpk(P_[B_+6], P_[B_+7]);                                             \
        auto r0 = __builtin_amdgcn_permlane32_swap(a0, b0, false, false); auto r1 = __builtin_amdgcn_permlane32_swap(a1, b1, false, false); \
        u32x4 w = {r0[0], r1[0], r0[1], r1[1]}; OUT = *reinterpret_cast<bf16x8*>(&w); } while (0)
    PK4(p, 0, pa0); PK4(p, 8, pa1);
#undef PK4
}
template <int KS>
__device__ __forceinline__ void pv_half(f32x16* o, int vb, bf16x8 pa0, bf16x8 pa1) {
#define TRRD(dst, off) asm volatile("ds_read_b64_tr_b16 %0, %1 offset:%2" : "=&v"(dst) : "v"(vb), "i"(off) : "memory")
#define FR(l, h) (bf16x8){l[0], l[1], l[2], l[3], h[0], h[1], h[2], h[3]}
#define PV_PAIR(da, db) do { s16x4 la0, ha0, la1, ha1, lb0, hb0, lb1, hb1;  \
        TRRD(la0, v_rd_off(da, KS, 0)); TRRD(ha0, v_rd_off(da, KS, 1)); TRRD(lb0, v_rd_off(db, KS, 0)); TRRD(hb0, v_rd_off(db, KS, 1)); \
        TRRD(la1, v_rd_off(da, KS + 1, 0)); TRRD(ha1, v_rd_off(da, KS + 1, 1)); TRRD(lb1, v_rd_off(db, KS + 1, 0)); TRRD(hb1, v_rd_off(db, KS + 1, 1)); \
        asm volatile("s_waitcnt lgkmcnt(0)" ::: "memory"); SBAR();   \
        o[da] = __builtin_amdgcn_mfma_f32_32x32x16_bf16(pa0, FR(la0, ha0), o[da], 0, 0, 0);   \
        o[db] = __builtin_amdgcn_mfma_f32_32x32x16_bf16(pa0, FR(lb0, hb0), o[db], 0, 0, 0);   \
        o[da] = __builtin_amdgcn_mfma_f32_32x32x16_bf16(pa1, FR(la1, ha1), o[da], 0, 0, 0);   \
        o[db] = __builtin_amdgcn_mfma_f32_32x32x16_bf16(pa1, FR(lb1, hb1), o[db], 0, 0, 0); } while (0)
    PV_PAIR(0, 1); PV_PAIR(2, 3);
#undef PV_PAIR
#undef FR
#undef TRRD
}
__device__ __forceinline__ unsigned v_src(int q) {
    const int st = q >> 5, within = q & 31, kr = within >> 2, cch = within & 3, kk = (st >> 2) * 8 + kr;
    const int k = (kk & ~0xC) | ((kk & 4) << 1) | ((kk & 8) >> 1), c = (st & 3) * 32 + cch * 8;
    return (unsigned)(k * 256 + c * 2);
}
#define GLDS16(gp, ldsoff) __builtin_amdgcn_global_load_lds((const unsigned*)(gp), (LAS unsigned*)(lds3 + (ldsoff)), 16, 0, 0)
#define DMA_TILE(Kp, Vp, k0, bi) do { const char* kt_ = (const char*)((Kp) + (size_t)(k0) * DQK); const char* vt_ = (const char*)((Vp) + (size_t)(k0) * DV); \
        const int kbo_ = 3 * SHM_V + (bi) * SHM_K + wid * 1024, vbo_ = (bi) * SHM_V + wid * 1024; \
        GLDS16(kt_ + koff0, kbo_); GLDS16(kt_ + koff1, kbo_ + 8192); GLDS16(kt_ + koff2, kbo_ + 16384); \
        GLDS16(vt_ + voff0, vbo_); GLDS16(vt_ + voff1, vbo_ + 8192); } while (0)
__device__ __forceinline__ void attn_block(const BlockRef& cur, char* lds) {
    const int tid = threadIdx.x, wid = __builtin_amdgcn_readfirstlane(tid >> 6), lane = tid & 63, r32 = lane & 31, hi = lane >> 5;
    const unsigned W = 1u << 30;
    const int T0 = cur.t0, T1 = cur.t1;
    const int qlo = cur.P0 + wid * QBLK, qm = qlo + r32 - 4 * hi;
    LAS unsigned char* lds3 = (LAS unsigned char*)lds;
    const int K3 = (int)(uintptr_t)lds + 3 * SHM_V;
    float* ws = (float*)(lds + 3 * SHM_V + 3 * SHM_K) + wid * 64; float* li_l = ws, * al_l = ws + 32;
    float m_reg = -1e30f, l_reg = 0; f32x16 o[4] = {};
    const int kp0 = wid * 64 + lane, kp1 = kp0 + 512, kp2 = kp0 + 1024;
    const unsigned koff0 = (kp0 / 24) * 384 + (((kp0 % 24) ^ ((kp0 / 24) & 7)) << 4), koff1 = (kp1 / 24) * 384 + (((kp1 % 24) ^ ((kp1 / 24) & 7)) << 4), koff2 = (kp2 / 24) * 384 + (((kp2 % 24) ^ ((kp2 / 24) & 7)) << 4);
    const unsigned voff0 = v_src(kp0), voff1 = v_src(kp0 + 512);
    const int vb0 = (int)(uintptr_t)lds + v_rd_base(lane);
    int ko[4];
#pragma unroll
    for (int dd = 0; dd < 4; ++dd) ko[dd] = KSWZ(r32, (dd * 16 + hi * 8) * 2);
    const bf16* Kh = cur.K; const bf16* Vh = cur.V;
#define RESC(a) do { if (__any((a) < 1.f)) { if (hi == 0) al_l[r32] = (a); asm volatile("s_waitcnt lgkmcnt(0)" ::: "memory");              \
                     for (int d_ = 0; d_ < 4; ++d_) for (int r = 0; r < 16; ++r) o[d_][r] *= al_l[crow(r, hi)]; } } while (0)
#define MASKH(P_, kb_) do { if ((kb_) + 31 > qlo) mask_half(P_, qm - (kb_), W); } while (0)
    __syncthreads();
    DMA_TILE(Kh, Vh, T0 * KVBLK, 0);
    if (T0 + 1 < T1) DMA_TILE(Kh, Vh, (T0 + 1) * KVBLK, 1);
    bf16x8 qr[12];
#pragma unroll
    for (int d0 = 0; d0 < 12; ++d0) qr[d0] = LD8(cur.Q + (size_t)(wid * QBLK + r32) * DQK + d0 * 16 + hi * 8);
    VMW();
    __syncthreads();
    f32x16 sA, sB; float al; bf16x8 pa0, pa1;
    qk_half(sA, K3, ko, qr);
    int i0 = 0, i1 = 1, i2 = 2;
    for (int t = T0; t < T1; ++t) {
        if (t > T0) { VMW(); __syncthreads(); }
        if (t + 2 < T1) DMA_TILE(Kh, Vh, (t + 2) * KVBLK, i2);
        SBAR();
        qk_half(sB, K3 + i0 * SHM_K + 32 * 384, ko, qr); SBAR();
        MASKH(sA, t * KVBLK); sm_half(sA, m_reg, l_reg, al, pa0, pa1); RESC(al); SBAR();
        pv_half<0>(o, vb0 + i0 * SHM_V, pa0, pa1); SBAR();
        if (t + 1 < T1) { qk_half(sA, K3 + i1 * SHM_K, ko, qr); } SBAR();
        MASKH(sB, t * KVBLK + 32); sm_half(sB, m_reg, l_reg, al, pa0, pa1); RESC(al); SBAR();
        pv_half<2>(o, vb0 + i0 * SHM_V, pa0, pa1); SBAR();
        { const int tmp = i0; i0 = i1; i1 = i2; i2 = tmp; }
    }
    bf16* Ow = cur.O + (size_t)(wid * QBLK) * DM;
    if (cur.part == nullptr) {
        if (hi == 0) li_l[r32] = l_reg; asm volatile("s_waitcnt lgkmcnt(0)" ::: "memory");
        float rli[16];
#pragma unroll
        for (int r = 0; r < 16; ++r) rli[r] = __builtin_amdgcn_rcpf(li_l[crow(r, hi)]);
#pragma unroll
        for (int r = 0; r < 16; ++r) { const int orow = crow(r, hi);
#pragma unroll
            for (int d0 = 0; d0 < 4; ++d0) { const float v = o[d0][r] * rli[r];
                const float vn = __shfl_xor(v, 1);
                if ((r32 & 1) == 0) *(unsigned*)(Ow + (size_t)orow * DM + d0 * 32 + r32) = cvtpk(v, vn); } }
    } else {
        float* mine = cur.part + tid;
#pragma unroll
        for (int d0 = 0; d0 < 4; ++d0)
#pragma unroll
            for (int r = 0; r < 16; ++r) __hip_atomic_store(mine + (d0 * 16 + r) * 512, o[d0][r], __ATOMIC_RELAXED, __HIP_MEMORY_SCOPE_AGENT);
        __hip_atomic_store(mine + 32768, m_reg, __ATOMIC_RELAXED, __HIP_MEMORY_SCOPE_AGENT);
        __hip_atomic_store(mine + 32768 + 512, l_reg, __ATOMIC_RELAXED, __HIP_MEMORY_SCOPE_AGENT);
        asm volatile("s_waitcnt vmcnt(0)" ::: "memory");
        __syncthreads();
        unsigned* fbox = (unsigned*)(lds + ATT_LDS);
        if (tid == 0) { *fbox = __hip_atomic_fetch_add(cur.flag, 1u, __ATOMIC_RELAXED, __HIP_MEMORY_SCOPE_AGENT); }
        __syncthreads();
        const unsigned old = *fbox;
        if (old == 1u) {
            const float* oth = cur.part_other + tid;
            constexpr float C2 = 1.4426950408889634f * SCALE;
            const float mo = __hip_atomic_load(oth + 32768, __ATOMIC_RELAXED, __HIP_MEMORY_SCOPE_AGENT), lo = __hip_atomic_load(oth + 32768 + 512, __ATOMIC_RELAXED, __HIP_MEMORY_SCOPE_AGENT);
            const float mm = fmaxf(m_reg, mo), fs = __builtin_amdgcn_exp2f((m_reg - mm) * C2), fo = __builtin_amdgcn_exp2f((mo - mm) * C2);
            const float il = 1.0f / (l_reg * fs + lo * fo);
            if (hi == 0) { li_l[r32] = fs * il; al_l[r32] = fo * il; }
            asm volatile("s_waitcnt lgkmcnt(0)" ::: "memory");
#pragma unroll
            for (int r = 0; r < 16; ++r) { const int orow = crow(r, hi); const float fa = li_l[orow], fb = al_l[orow];
#pragma unroll
                for (int d0 = 0; d0 < 4; ++d0) { const float v = o[d0][r] * fa + __hip_atomic_load(oth + (d0 * 16 + r) * 512, __ATOMIC_RELAXED, __HIP_MEMORY_SCOPE_AGENT) * fb;
                    const float vn = __shfl_xor(v, 1);
                    if ((r32 & 1) == 0) *(unsigned*)(Ow + (size_t)orow * DM + d0 * 32 + r32) = cvtpk(v, vn); }
                if ((r & 3) == 3) asm volatile("" ::: "memory"); }
        }
        __syncthreads();
    }
#undef RESC
#undef MASKH
}
#undef VMW
#undef GLDS16
#undef DMA_TILE
#undef LD8
}

#define XB_TMO      128
#define XB_XCNT(j)  (256  + 64 * (j))
#define XB_XSUB(j)  (1280 + 64 * (j))
#define XB_XGEN(j)  (2304 + 64 * (j))
#define XB_TOP      3328
#define XB_TOPGEN   3392
#define XCD_BAR_WORDS 3456
#define XB_SPIN_CAP (1u << 18)

__device__ __forceinline__ unsigned xb_ld(unsigned* p)              { return __hip_atomic_load(p, __ATOMIC_RELAXED, __HIP_MEMORY_SCOPE_AGENT); }
__device__ __forceinline__ unsigned xb_add(unsigned* p, unsigned v) { return __hip_atomic_fetch_add(p, v, __ATOMIC_RELAXED, __HIP_MEMORY_SCOPE_AGENT); }
__device__ __forceinline__ unsigned xb_xcc_id() { return (unsigned)__builtin_amdgcn_s_getreg((3 << 11) | 20) & 0xFu; }
#define XB_SPIN(cond, bar) do { unsigned _sp = 0; while (cond) { __builtin_amdgcn_s_sleep(1); \
    if ((++_sp & 255u) == 0u) { if (xb_ld(&(bar)[XB_TMO])) break; if (_sp > XB_SPIN_CAP) { atomicAdd(&(bar)[XB_TMO], 1u); break; } } } } while (0)

struct XcdBarrier {
    unsigned* bar; unsigned x;
    volatile LAS unsigned* st;
};

__device__ __forceinline__ XcdBarrier xcd_barrier_post(unsigned* bar, volatile LAS unsigned* st) {
    XcdBarrier b; b.bar = bar; b.x = xb_xcc_id(); b.st = st;
    if (threadIdx.x == 0) (void)xb_add(&bar[XB_XCNT(b.x)], 1u);
    return b;
}
__device__ __forceinline__ void xcd_barrier_complete(unsigned* bar, unsigned x, unsigned& nloc, unsigned& nx) {
    const unsigned G = gridDim.x * gridDim.y * gridDim.z;
    unsigned sum, cnt, mine, sp = 0u;
    for (;;) {
        sum = 0u; cnt = 0u; mine = 0u;
#pragma unroll
        for (unsigned j = 0; j < 16; ++j) { const unsigned c = xb_ld(&bar[XB_XCNT(j)]); sum += c; cnt += (c > 0u) ? 1u : 0u; mine = (j == x) ? c : mine; }
        if (sum == G) break;
        __builtin_amdgcn_s_sleep(1);
        if ((++sp & 255u) == 0u) { if (xb_ld(&bar[XB_TMO])) break; if (sp > XB_SPIN_CAP) { atomicAdd(&bar[XB_TMO], 1u); break; } }
    }
    nloc = mine > 0u ? mine : 1u; nx = cnt > 0u ? cnt : 1u;
}

__device__ __forceinline__ void xcd_barrier(const XcdBarrier& b) {
    asm volatile("s_waitcnt vmcnt(0)" ::: "memory");
    __syncthreads();
    if (threadIdx.x == 0) {
        unsigned* bar = b.bar;
        __builtin_amdgcn_s_waitcnt(0);
        unsigned nloc = b.st[0], nx = b.st[1];
        if (nloc == 0u) { xcd_barrier_complete(bar, b.x, nloc, nx); b.st[0] = nloc; b.st[1] = nx; }
        const unsigned old = xb_add(&bar[XB_XSUB(b.x)], 1u);
        const unsigned gen = old / nloc;
        if (old + 1u == (gen + 1u) * nloc) {
            __builtin_amdgcn_fence(__ATOMIC_RELEASE, "agent");
            asm volatile("s_waitcnt vmcnt(0)" ::: "memory");
            const unsigned og = xb_add(&bar[XB_TOP], 1u);
            const unsigned tg = og / nx;
            if (og + 1u == (tg + 1u) * nx) xb_add(&bar[XB_TOPGEN], 1u);
            else XB_SPIN(xb_ld(&bar[XB_TOPGEN]) == tg, bar);
            __builtin_amdgcn_fence(__ATOMIC_ACQUIRE, "agent");
            xb_add(&bar[XB_XGEN(b.x)], 1u);
            asm volatile("s_waitcnt vmcnt(0)" ::: "memory");
        } else {
            XB_SPIN(xb_ld(&bar[XB_XGEN(b.x)]) == gen, bar);
            __builtin_amdgcn_fence(__ATOMIC_ACQUIRE, "agent");
            asm volatile("s_waitcnt vmcnt(0)" ::: "memory");
        }
    }
    __syncthreads();
}

struct Args {
    const float *x; const int* pos; const float *w_in, *q_g, *w_uq, *kv_g, *w_ukv, *conv_w, *w_out, *ln1_g, *ln1_b, *w_gu, *ffn_cw, *w_down, *ln2_g, *ln2_b;
    float* out; unsigned char* ws; int ph_lo, ph_hi;
};

__device__ __forceinline__ float wave_sum(float v) {
#pragma unroll
    for (int o = 1; o < 64; o <<= 1) v += __shfl_xor(v, o);
    return v;
}
__device__ __forceinline__ int map_win(int n0) {
    if (n0 < 768) return n0;
    if (n0 == 768) return 768;
    if (n0 == 800) return 896;
    if (n0 < 1856) return 1024 + (n0 - 832);
    if (n0 < 2880) { const int t = n0 - 1856; return 2048 + 256 * (t >> 7) + (t & 127); }
    { const int t = n0 - 2880; return 2048 + 256 * (t >> 7) + 128 + (t & 127); }
}
__device__ __forceinline__ int map_wuq(int n0) {
    const int h = n0 / 192, d = n0 % 192;
    if (d < 128) return h * 128 + d;
    if (d == 128) return 1024 + (h >> 2) * 256 + (h & 3) * 32;
    return 1024 + (h >> 2) * 256 + 128 + (h & 3) * 32;
}
__device__ __forceinline__ int map_wgu(int n0) {
    if (n0 < FF) return 256 * (n0 >> 7) + (n0 & 127);
    const int t = n0 - FF; return 256 * (t >> 7) + 128 + (t & 127);
}
struct TJob { const float* W; const float* g; bf16* WT; int K, N, k0, n0, mat; };
__device__ __forceinline__ int map_col_rt(int mat, int nb) { return mat == 0 ? map_win(nb) : mat == 1 ? map_wuq(nb) : mat == 4 ? map_wgu(nb) : nb; }
__device__ __forceinline__ void tt_load(const TJob& j, f32x4 (&v)[8], int tid) {
    const int w = tid >> 6, l = tid & 63, n = j.n0 + 4 * l;
#pragma unroll
    for (int i = 0; i < 8; ++i) { const int k = 8 * i + w;
        v[i] = (n < j.N) ? __builtin_nontemporal_load((const f32x4*)(j.W + (size_t)(j.k0 + k) * j.N + n)) : (f32x4){0.f, 0.f, 0.f, 0.f}; }
}
__device__ __forceinline__ void tt_to_lds(const TJob& j, const f32x4 (&v)[8], LAS unsigned char* scr, int tid) {
    const int w = tid >> 6, l = tid & 63;
#pragma unroll
    for (int i = 0; i < 8; ++i) { const int k = 8 * i + w; f32x4 x = v[i]; if (j.g) x = x * j.g[j.k0 + k];
        LAS unsigned* p = (LAS unsigned*)(scr + k * 516 + 8 * l); p[0] = cvtpk(x[0], x[1]); p[1] = cvtpk(x[2], x[3]); }
}
__device__ __forceinline__ void tt_emit(const TJob& j, LAS unsigned char* scr, int tid) {
#pragma unroll
    for (int jj = 0; jj < 4; ++jj) { const int c = tid + 512 * jj, nn = c >> 3, kc = c & 7;
        const LAS unsigned short* q = (const LAS unsigned short*)(scr + (8 * kc) * 516 + 2 * nn);
        u32x4 o; o.x = (unsigned)q[0] | ((unsigned)q[258] << 16); o.y = (unsigned)q[2 * 258] | ((unsigned)q[3 * 258] << 16);
        o.z = (unsigned)q[4 * 258] | ((unsigned)q[5 * 258] << 16); o.w = (unsigned)q[6 * 258] | ((unsigned)q[7 * 258] << 16);
        const int ns = j.n0 + nn;
        if (ns < j.N) *(u32x4*)(j.WT + (size_t)(map_col_rt(j.mat, ns & ~31) + (ns & 31)) * j.K + j.k0 + 8 * kc) = o; }
}
__device__ __forceinline__ void sincos_acc(float x, float& s, float& c) {
    const double xd = (double)x;
    const double k = __builtin_rint(xd * 0.63661977236758134308);
    double r = __builtin_fma(-k, 1.57079632679489655800, xd); r = __builtin_fma(-k, 6.12323399573676603587e-17, r);
    const int q = ((int)k) & 3;
    const float rf = (float)r, r2 = rf * rf;
    const float sp = rf * (1.0f + r2 * (-1.6666667e-1f + r2 * (8.3333333e-3f + r2 * (-1.9841270e-4f + r2 * 2.7557319e-6f))));
    const float cp = 1.0f + r2 * (-0.5f + r2 * (4.1666667e-2f + r2 * (-1.3888889e-3f + r2 * (2.4801587e-5f + r2 * -2.7557319e-7f))));
    s = (q == 0) ? sp : (q == 1) ? cp : (q == 2) ? -sp : -cp;
    c = (q == 0) ? cp : (q == 1) ? -sp : (q == 2) ? -cp : sp;
}

__global__ void __launch_bounds__(NTHREADS, 2) mega_fwd(Args a) {
    extern __shared__ __attribute__((aligned(16))) unsigned char lds[];
    cg::grid_group grid = cg::this_grid();
    const int tid = threadIdx.x, lane = tid & 63, wave = __builtin_amdgcn_readfirstlane(tid >> 6);
    const int G = gridDim.x, bx = blockIdx.x;
    const int gw = bx * NWAVES + wave, NGW = G * NWAVES;
    unsigned char* ws = a.ws;
    float* ssq_q = (float*)(ws + WS_SSQQ); float* ssq_kv = (float*)(ws + WS_SSQKV); float* cs = (float*)(ws + WS_CS);
    bf16* Wd_t = (bf16*)(ws + WS_WD); bf16* Win_t = (bf16*)(ws + WS_WIN); bf16* Wuq_t = (bf16*)(ws + WS_WUQ); bf16* Wukv_t = (bf16*)(ws + WS_WUKV);
    bf16* Wout_t = (bf16*)(ws + WS_WOUT); bf16* Wgu_t = (bf16*)(ws + WS_WGU);
    bf16* X1b = (bf16*)(ws + WS_X1B); bf16* Xb = (bf16*)(ws + WS_XB); bf16* CQ = (bf16*)(ws + WS_CQ); bf16* CKV = (bf16*)(ws + WS_CKV);
    bf16* GBb = (bf16*)(ws + WS_GB); bf16* Pb = (bf16*)(ws + WS_P); bf16* Qb = (bf16*)(ws + WS_Q); bf16* Kb = (bf16*)(ws + WS_K); bf16* Vb = (bf16*)(ws + WS_V);
    bf16* MIX = (bf16*)(ws + WS_MIX); bf16* GU = (bf16*)(ws + WS_GU); bf16* ACT = (bf16*)(ws + WS_ACT);
    const int lo = a.ph_lo, hi_ = a.ph_hi;
    volatile LAS unsigned* xst = (volatile LAS unsigned*)((LAS unsigned char*)lds + 131072 + 128);
    if (tid == 0) { xst[0] = 0u; xst[1] = 0u; }
    __syncthreads();
    XcdBarrier xbar = xcd_barrier_post((unsigned*)(ws + WS_BAR), xst);
    if (hi_ > 1000) grid.sync();
#define IN(k) (lo <= (k) && (k) < hi_)
#ifdef PROBE_PHASE
#define PT_LDS ((volatile LAS unsigned long long*)((LAS unsigned char*)lds + 131072 + 256))
#define SEAM(k) do { if (IN(k) && IN((k) + 1)) xcd_barrier(xbar); \
    if (bx == 0 && tid == 0) { if ((k) + 1 == PROBE_PHASE) PT_LDS[0] = __builtin_amdgcn_s_memrealtime(); if ((k) == PROBE_PHASE) PT_LDS[1] = __builtin_amdgcn_s_memrealtime(); } } while (0)
#else
#define SEAM(k) do { if (IN(k) && IN((k) + 1)) xcd_barrier(xbar); } while (0)
#endif
    Epi E; E.mode = 0; E.CQ = CQ; E.CKV = CKV; E.GB = GBb; E.P = Pb; E.Q = Qb; E.K = Kb; E.V = Vb; E.GU = GU; E.ssq_q = ssq_q; E.ssq_kv = ssq_kv; E.cs = cs; E.x = a.x; E.out = a.out;
    PG8_LAS unsigned char* ring = (PG8_LAS unsigned char*)lds;

    if (IN(0)) {
        LAS unsigned char* scr = (LAS unsigned char*)lds;
        constexpr int I0 = (DM / 64) * 16, I1 = (QL / 64) * 6, I2 = (KVL / 64) * 8, I3 = (DM / 64) * 8, I4 = (DM / 64) * 44, I5 = (FF / 64) * 8;
        constexpr int NIT = I0 + I1 + I2 + I3 + I4 + I5;
#define TJOB(J, it_) do { int r = (it_); \
            if (r < I4) { J = TJob{a.w_gu, nullptr, Wgu_t, DM, NGU, (r / 44) * 64, (r % 44) * 256, 4}; } else { r -= I4; \
            if (r < I5) { J = TJob{a.w_down, nullptr, Wd_t, FF, DM, (r / 8) * 64, (r % 8) * 256, 5}; } else { r -= I5; \
            if (r < I0) { J = TJob{a.w_in, nullptr, Win_t, DM, NIN, (r / 16) * 64, (r % 16) * 256, 0}; } else { r -= I0; \
            if (r < I3) { J = TJob{a.w_out, nullptr, Wout_t, DM, DM, (r / 8) * 64, (r % 8) * 256, 3}; } else { r -= I3; \
            if (r < I1) { J = TJob{a.w_uq, a.q_g, Wuq_t, QL, 1536, (r / 6) * 64, (r % 6) * 256, 1}; } else { r -= I1; \
            J = TJob{a.w_ukv, a.kv_g, Wukv_t, KVL, 2048, (r / 8) * 64, (r % 8) * 256, 2}; } } } } } } while (0)
        if (bx < NIT) {
            TJob J, Jn; f32x4 v[8];
            TJOB(J, bx); tt_load(J, v, tid);
#pragma nounroll
            for (int it = bx; it < NIT; it += G) {
                tt_to_lds(J, v, scr, tid);
                __syncthreads();
                const bool more = it + G < NIT;
                if (more) { TJOB(Jn, it + G); tt_load(Jn, v, tid); }
                tt_emit(J, scr, tid);
                __syncthreads();
                if (more) J = Jn;
            }
        }
#undef TJOB
        for (int rr = gw; rr < 192; rr += NGW) { const int row = rr < 96 ? 800 + rr : 928 + (rr - 96);
            u32x4* p = (u32x4*)(Win_t + (size_t)row * DM); const u32x4 z = {0u, 0u, 0u, 0u};
#pragma unroll
            for (int j = 0; j < 4; ++j) p[lane + 64 * j] = z; }
        for (int m = gw; m < M; m += NGW) { const f32x4* xr = (const f32x4*)(a.x + (size_t)m * DM); u32x4* o = (u32x4*)(Xb + (size_t)m * DM);
#pragma unroll
            for (int j = 0; j < 4; ++j) { const f32x4 v0 = xr[2 * (lane + 64 * j)], v1 = xr[2 * (lane + 64 * j) + 1]; o[lane + 64 * j] = pack8(v0, v1); } }
        for (int i = bx * NTHREADS + tid; i < M; i += G * NTHREADS) { ssq_q[i] = 0.f; ssq_kv[i] = 0.f; }
        if (bx == 0 && tid < 128) ((unsigned*)(ws + WS_AFLAG))[tid] = 0u;
        for (int i = bx * NTHREADS + tid; i < M * 32; i += G * NTHREADS) { const int row = i >> 5, f = i & 31;
            const float inv = (float)exp2(-(double)f * (13.287712379549449 / 32.0));
            const float ang = (float)a.pos[row] * inv; float s, c; sincos_acc(ang, s, c);
            cs[(size_t)row * 64 + f] = c; cs[(size_t)row * 64 + 32 + f] = s; }
    }
    SEAM(0);
    if (IN(1)) {
        pg8::Gemm g{Xb, Win_t, M, NINP, DM}; pg8::StaticOrder S; S.init(M, NINP, G, bx); E.mode = 1;
        pg8::gemm_phase<Epi, pg8::StaticOrder, true, true>(ring, g, S, E);
    }
    SEAM(1);
    if (IN(2)) {
        { pg8::Gemm g{CQ, Wuq_t, M, 1536, QL}; pg8::StaticOrder S; S.init(M, 1536, G, bx); E.mode = 2;
          pg8::gemm_phase<Epi, pg8::StaticOrder, true, true>(ring, g, S, E); }
        { pg8::Gemm g{CKV, Wukv_t, M, 2048, KVL}; pg8::StaticOrder S; S.init(M, 2048, G, bx); E.mode = 3;
          pg8::gemm_phase<Epi, pg8::StaticOrder, true, true>(ring, g, S, E); }
        { const int cc = tid & 127, rg = tid >> 7;
          float w0[8], w1[8], w2[8];
#pragma unroll
          for (int j = 0; j < 8; ++j) { w0[j] = a.conv_w[cc * 8 + j]; w1[j] = a.conv_w[CW + cc * 8 + j]; w2[j] = a.conv_w[2 * CW + cc * 8 + j]; }
          for (int it = bx; it < M / 32; it += G) {
              const int r0 = it * 32 + rg * 8;
              float pm2[8], pm1[8];
              if ((r0 & (SEQ - 1)) == 0) {
#pragma unroll
                  for (int j = 0; j < 8; ++j) { pm2[j] = 0.f; pm1[j] = 0.f; }
              } else { unpack8(*(const u32x4*)(Pb + (size_t)(r0 - 2) * CW + cc * 8), pm2); unpack8(*(const u32x4*)(Pb + (size_t)(r0 - 1) * CW + cc * 8), pm1); }
#pragma unroll
              for (int r = 0; r < 8; ++r) { float pc[8], gb[8], o[8];
                  unpack8(*(const u32x4*)(Pb + (size_t)(r0 + r) * CW + cc * 8), pc); unpack8(*(const u32x4*)(GBb + (size_t)(r0 + r) * CW + cc * 8), gb);
#pragma unroll
                  for (int j = 0; j < 8; ++j) { o[j] = gb[j] * (w2[j] * pc[j] + w1[j] * pm1[j] + w0[j] * pm2[j]); pm2[j] = pm1[j]; pm1[j] = pc[j]; }
                  u32x4 w = {cvtpk(o[0], o[1]), cvtpk(o[2], o[3]), cvtpk(o[4], o[5]), cvtpk(o[6], o[7])};
                  *(u32x4*)(MIX + (size_t)(r0 + r) * DM + CW + cc * 8) = w; }
          } }
    }
    SEAM(2);
    if (IN(3)) {
        float* PART = (float*)(ws + WS_PART); unsigned* AFLAG = (unsigned*)(ws + WS_AFLAG);
        constexpr int PSZ = 64 * 512 + 1024;
#pragma nounroll
        for (int uu = bx; uu < 256; uu += G) {
            const int xcd = uu & 7, idx = uu >> 3;
            const int bh = 2 * xcd + (idx >> 4), xq = (idx >> 1) & 7, role = idx & 1;
            const bf16* Qh = Qb + (size_t)bh * SEQ * DQK; const bf16* Kh = Kb + (size_t)bh * SEQ * DQK; const bf16* Vh = Vb + (size_t)bh * SEQ * DV;
            bf16* Oh = MIX + (size_t)(bh >> 3) * SEQ * DM + (bh & 7) * DV;
            const int hq = 15 - xq;
            float* pb = PART + (size_t)(bh * 8 + xq) * 2 * PSZ;
            att::BlockRef hb{Qh + (size_t)hq * 256 * DQK, Kh, Vh, Oh + (size_t)hq * 256 * DM, hq * 256, 0, 34, pb + role * PSZ, pb + (1 - role) * PSZ, AFLAG + bh * 8 + xq};
            att::BlockRef cur = hb;
            if (role != 0) {
                hb.t0 = 34; hb.t1 = 4 * (hq + 1);
                cur = att::BlockRef{Qh + (size_t)xq * 256 * DQK, Kh, Vh, Oh + (size_t)xq * 256 * DM, xq * 256, 0, 4 * (xq + 1), nullptr, nullptr, nullptr};
            }
#pragma nounroll
            for (int i = 0; i <= role; ++i) { att::attn_block(cur, (char*)lds); cur = hb; }
        }
    }
    SEAM(3);
    if (IN(4)) {
        pg8::Gemm g{MIX, Wout_t, M, DM, DM}; pg8::StaticOrder S; S.init(M, DM, G, bx); E.mode = 4;
        pg8::gemm_phase<Epi, pg8::StaticOrder, true, true>(ring, g, S, E);
    }
    SEAM(4);
    if (IN(5)) {
        for (int m = gw; m < M; m += NGW) {
            f32x4* xr = (f32x4*)(a.out + (size_t)m * DM) + lane; f32x4 v[8]; float s = 0.f;
#pragma unroll
            for (int j = 0; j < 8; ++j) { v[j] = xr[64 * j]; s += (v[j][0] + v[j][1]) + (v[j][2] + v[j][3]); }
            const float mean = wave_sum(s) * (1.f / DM); float s2 = 0.f;
#pragma unroll
            for (int j = 0; j < 8; ++j) { v[j] = v[j] - mean; s2 += (v[j][0] * v[j][0] + v[j][1] * v[j][1]) + (v[j][2] * v[j][2] + v[j][3] * v[j][3]); }
            const float rstd = 1.f / sqrtf(wave_sum(s2) * (1.f / DM) + LN_EPS);
            u32x2* ob = (u32x2*)(X1b + (size_t)m * DM) + lane;
#pragma unroll
            for (int j = 0; j < 8; ++j) { const f32x4 gg = ((const f32x4*)a.ln1_g)[lane + 64 * j], bb = ((const f32x4*)a.ln1_b)[lane + 64 * j];
                const f32x4 y = v[j] * rstd * gg + bb; xr[64 * j] = y; u32x2 w = {cvtpk(y[0], y[1]), cvtpk(y[2], y[3])}; ob[64 * j] = w; }
        }
    }
    SEAM(5);
    if (IN(6)) {
        pg8::Gemm g{X1b, Wgu_t, M, NGU, DM}; pg8::StaticOrder S; S.init(M, NGU, G, bx); E.mode = 5;
        pg8::gemm_phase<Epi, pg8::StaticOrder, true, true>(ring, g, S, E);
    }
    SEAM(6);
    if (IN(7)) {
        const int NCC = NGU / 16;
        const long total = (long)NCC * (M / 8);
        for (long uu = (long)bx * NTHREADS + tid; uu < total; uu += (long)G * NTHREADS) {
            const int cc = (int)(uu % NCC), rb = (int)(uu / NCC), r0 = rb * 8;
            const int j = cc >> 4, r8 = (cc & 15) * 8;
            const int cg_ = j * 128 + r8, cu_ = FF + cg_;
            const bf16* gp = GU + (size_t)j * 256 + r8; const bf16* up = gp + 128;
            float wg0[8], wg1[8], wg2[8], wu0[8], wu1[8], wu2[8];
#pragma unroll
            for (int q = 0; q < 8; ++q) { wg0[q] = a.ffn_cw[cg_ + q]; wg1[q] = a.ffn_cw[NGU + cg_ + q]; wg2[q] = a.ffn_cw[2 * NGU + cg_ + q];
                wu0[q] = a.ffn_cw[cu_ + q]; wu1[q] = a.ffn_cw[NGU + cu_ + q]; wu2[q] = a.ffn_cw[2 * NGU + cu_ + q]; }
            float g2[8], g1[8], u2[8], u1[8];
            if ((r0 & (SEQ - 1)) == 0) {
#pragma unroll
                for (int q = 0; q < 8; ++q) { g2[q] = 0.f; g1[q] = 0.f; u2[q] = 0.f; u1[q] = 0.f; }
            } else { unpack8(*(const u32x4*)(gp + (size_t)(r0 - 2) * NGU), g2); unpack8(*(const u32x4*)(gp + (size_t)(r0 - 1) * NGU), g1);
                     unpack8(*(const u32x4*)(up + (size_t)(r0 - 2) * NGU), u2); unpack8(*(const u32x4*)(up + (size_t)(r0 - 1) * NGU), u1); }
#pragma unroll
            for (int r = 0; r < 8; ++r) { float gc[8], uc[8], o[8];
                unpack8(*(const u32x4*)(gp + (size_t)(r0 + r) * NGU), gc); unpack8(*(const u32x4*)(up + (size_t)(r0 + r) * NGU), uc);
#pragma unroll
                for (int q = 0; q < 8; ++q) { const float gv = wg2[q] * gc[q] + wg1[q] * g1[q] + wg0[q] * g2[q], uv = wu2[q] * uc[q] + wu1[q] * u1[q] + wu0[q] * u2[q];
                    o[q] = gv / (1.f + __expf(-gv)) * uv; g2[q] = g1[q]; g1[q] = gc[q]; u2[q] = u1[q]; u1[q] = uc[q]; }
                u32x4 w = {cvtpk(o[0], o[1]), cvtpk(o[2], o[3]), cvtpk(o[4], o[5]), cvtpk(o[6], o[7])};
                *(u32x4*)(ACT + (size_t)(r0 + r) * FF + cg_) = w; }
        }
    }
    SEAM(7);
    if (IN(8)) {
        pg8::Gemm g{ACT, Wd_t, M, DM, FF}; pg8::StaticOrder S; S.init(M, DM, G, bx); E.mode = 6;
        pg8::gemm_phase<Epi, pg8::StaticOrder, true, true>(ring, g, S, E);
    }
    SEAM(8);
    if (IN(9)) {
        for (int m = gw; m < M; m += NGW) {
            f32x4* xr = (f32x4*)(a.out + (size_t)m * DM) + lane; f32x4 v[8]; float s = 0.f;
#pragma unroll
            for (int j = 0; j < 8; ++j) { v[j] = xr[64 * j]; s += (v[j][0] + v[j][1]) + (v[j][2] + v[j][3]); }
            const float mean = wave_sum(s) * (1.f / DM); float s2 = 0.f;
#pragma unroll
            for (int j = 0; j < 8; ++j) { v[j] = v[j] - mean; s2 += (v[j][0] * v[j][0] + v[j][1] * v[j][1]) + (v[j][2] * v[j][2] + v[j][3] * v[j][3]); }
            const float rstd = 1.f / sqrtf(wave_sum(s2) * (1.f / DM) + LN_EPS);
#pragma unroll
            for (int j = 0; j < 8; ++j) { const f32x4 gg = ((const f32x4*)a.ln2_g)[lane + 64 * j], bb = ((const f32x4*)a.ln2_b)[lane + 64 * j];
                xr[64 * j] = v[j] * rstd * gg + bb; }
        }
    }
#ifdef PROBE_PHASE
    if (bx == 0 && tid == 0) {
        const unsigned long long t1 = (PROBE_PHASE == 9) ? __builtin_amdgcn_s_memrealtime() : PT_LDS[1];
        const unsigned long long t0 = (PROBE_PHASE == 0) ? t1 : PT_LDS[0];
        const unsigned long long target = 10ull * (t1 - t0), ts = __builtin_amdgcn_s_memrealtime();
        while (__builtin_amdgcn_s_memrealtime() - ts < target) __builtin_amdgcn_s_sleep(8);
    }
#endif
#undef IN
#undef SEAM
}

#ifndef MK_PER_PHASE
#define MK_PER_PHASE 0
#endif
constexpr int NPHASE = 10;
extern "C" void kernel_launch(void* const* d_in, const int* in_sizes, int n_in, void* d_out, int out_size, void* d_ws, size_t ws_size, hipStream_t stream) {
    static int grid = 0;
    if (grid == 0) {
        if (n_in != 16 || in_sizes[0] != M * DM || out_size != M * DM || ws_size < WS_END) { fprintf(stderr, "kernel_launch: unexpected shapes (n_in %d, ws %zu)\n", n_in, ws_size); grid = -1; return; }
        int dev = 0, cus = 0, per_cu = 0;
        (void)hipGetDevice(&dev); (void)hipDeviceGetAttribute(&cus, hipDeviceAttributeMultiprocessorCount, dev);
        if (hipFuncSetAttribute((const void*)mega_fwd, hipFuncAttributeMaxDynamicSharedMemorySize, LDS_BYTES) != hipSuccess) { fprintf(stderr, "kernel_launch: hipFuncSetAttribute failed\n"); grid = -1; return; }
        if (hipOccupancyMaxActiveBlocksPerMultiprocessor(&per_cu, (const void*)mega_fwd, NTHREADS, LDS_BYTES) != hipSuccess || per_cu < 1) { fprintf(stderr, "kernel_launch: occupancy query says %d\n", per_cu); per_cu = 1; }
        (void)hipGetLastError();
        grid = cus > 0 ? cus : 256;
    }
    if (grid < 0) return;
    Args a{};
    a.x = (const float*)d_in[0]; a.pos = (const int*)d_in[1]; a.w_in = (const float*)d_in[2]; a.q_g = (const float*)d_in[3]; a.w_uq = (const float*)d_in[4];
    a.kv_g = (const float*)d_in[5]; a.w_ukv = (const float*)d_in[6]; a.conv_w = (const float*)d_in[7]; a.w_out = (const float*)d_in[8]; a.ln1_g = (const float*)d_in[9];
    a.ln1_b = (const float*)d_in[10]; a.w_gu = (const float*)d_in[11]; a.ffn_cw = (const float*)d_in[12]; a.w_down = (const float*)d_in[13]; a.ln2_g = (const float*)d_in[14]; a.ln2_b = (const float*)d_in[15];
    a.out = (float*)d_out; a.ws = (unsigned char*)d_ws;
#if MK_PER_PHASE
    for (int p = 0; p < NPHASE; ++p) { a.ph_lo = p; a.ph_hi = p + 1; hipLaunchKernelGGL(mega_fwd, dim3(grid), dim3(NTHREADS), LDS_BYTES, stream, a); }
#else
    (void)hipMemsetAsync((unsigned char*)d_ws + WS_BAR, 0, WS_BAR_BYTES, stream);
    a.ph_lo = 0; a.ph_hi = NPHASE;
    void* args[] = {&a};
    hipError_t e = hipLaunchCooperativeKernel((const void*)mega_fwd, dim3(grid), dim3(NTHREADS), args, LDS_BYTES, stream);
    if (e != hipSuccess) fprintf(stderr, "cooperative launch failed: %s (grid %d)\n", hipGetErrorString(e), grid);
#endif
}
```
